# Optimizing an MI355X kernel written in HIP

```python
import jax, jax.numpy as jnp
from jax import lax
import numpy as np

D_MODEL = 1024
BATCH = 4
SEQ = 4096
DEPTH = 4

CHUNK = 64
Q_BLOCK = 128
D_FF = 2816
EPS = 1e-6

MLA_HEADS = 8
MLA_NOPE = 64
MLA_ROPE = 32
MLA_QK = MLA_NOPE + MLA_ROPE
MLA_V = 64
Q_LORA = 256
KV_LORA = 128
ROPE_BASE = 10000.0

RWKV_HEADS = 8
RWKV_HEAD = 64
RWKV_W = RWKV_HEADS * RWKV_HEAD
DECAY_LORA = 64
A_LORA = 64
GATE_LORA = 160
GN_EPS = 64e-5

MLA_W = MLA_HEADS * MLA_V
MIX_W = MLA_W + RWKV_W
MLA_IN = Q_LORA + KV_LORA + MLA_ROPE
RWKV_SIZES = (RWKV_W, DECAY_LORA, RWKV_W, RWKV_W, A_LORA, GATE_LORA)
RWKV_IN = sum(RWKV_SIZES)
N_IN = MLA_IN + RWKV_IN

kernel_name = 'hybrid_mla_rwkv7_macaron_encoder'

f32 = jnp.float32


def _split(x, sizes):
    idx, acc = [], 0
    for s in sizes[:-1]:
        acc += s
        idx.append(acc)
    return jnp.split(x, idx, axis=-1)


def _rms_norm(x, g):
    xf = x.astype(f32)
    y = xf * lax.rsqrt(jnp.mean(xf * xf, axis=-1, keepdims=True) + EPS)
    return (y * g.astype(f32)).astype(x.dtype)


def _swiglu(h, w_gate, w_up, w_down):
    return (jax.nn.silu(h @ w_gate) * (h @ w_up)) @ w_down


def _rope_tables(seq):
    pos = jnp.arange(seq, dtype=f32)
    inv_freq = ROPE_BASE ** (-jnp.arange(0, MLA_ROPE, 2, dtype=f32) / MLA_ROPE)
    ang = pos[:, None] * inv_freq[None, :]
    return jnp.cos(ang)[None, :, None, :], jnp.sin(ang)[None, :, None, :]


def _rope_tail(x, cos, sin):
    nope, pe = x[..., :MLA_NOPE], x[..., MLA_NOPE:].astype(f32)
    half = MLA_ROPE // 2
    x1, x2 = pe[..., :half], pe[..., half:]
    rot = jnp.concatenate([x1 * cos - x2 * sin, x2 * cos + x1 * sin], axis=-1).astype(x.dtype)
    return jnp.concatenate([nope, rot], axis=-1)


def _chunk_causal_attention(q, k, v):
    B, S, H, Dq = q.shape
    Dv = v.shape[-1]
    nb = S // Q_BLOCK
    scale = MLA_QK ** -0.5
    qt = q.transpose(0, 2, 1, 3).reshape(B, H, nb, Q_BLOCK, Dq).transpose(2, 0, 1, 3, 4)
    kt = k.transpose(0, 2, 1, 3)
    vt = v.transpose(0, 2, 1, 3)
    key_chunk = jnp.arange(S) // CHUNK

    def block(args):
        qb, i = args
        s = jnp.einsum('bhqd,bhkd->bhqk', qb, kt).astype(f32) * scale
        q_chunk = (i * Q_BLOCK + jnp.arange(Q_BLOCK)) // CHUNK
        mask = key_chunk[None, :] <= q_chunk[:, None]
        s = jnp.where(mask[None, None], s, -jnp.inf)
        pr = jax.nn.softmax(s, axis=-1).astype(vt.dtype)
        return jnp.einsum('bhqk,bhkd->bhqd', pr, vt)

    o = lax.map(block, (qt, jnp.arange(nb)))
    return o.transpose(1, 0, 3, 2, 4).reshape(B, S, H * Dv)


def _mla(p, q_lat_norm, w_q_up, kv_lat_norm, w_kv_up, q_norm, k_norm, cos, sin):
    B, S, _ = p.shape
    q_lat, kv_lat, k_pe = _split(p, [Q_LORA, KV_LORA, MLA_ROPE])
    q = (_rms_norm(q_lat, q_lat_norm) @ w_q_up).reshape(B, S, MLA_HEADS, MLA_QK)
    kv = (_rms_norm(kv_lat, kv_lat_norm) @ w_kv_up).reshape(B, S, MLA_HEADS, MLA_NOPE + MLA_V)
    k_nope, v = kv[..., :MLA_NOPE], kv[..., MLA_NOPE:]
    k = jnp.concatenate([k_nope, jnp.broadcast_to(k_pe[:, :, None, :], (B, S, MLA_HEADS, MLA_ROPE))], axis=-1)
    q = _rope_tail(_rms_norm(q, q_norm), cos, sin)
    k = _rope_tail(_rms_norm(k, k_norm), cos, sin)
    return _chunk_causal_attention(q, k, v)


def _rwkv7(p, mu, w0, w2, a0, a2, g2, k_k, k_a, r_k, gn_gain, gn_bias):
    B, S, _ = p.shape
    prev = jnp.pad(p[:, :-1], ((0, 0), (1, 0), (0, 0)))
    p = p + mu * (prev - p)
    r, w_l, k, v, a_l, g_l = _split(p, list(RWKV_SIZES))
    w = -jax.nn.softplus(-(w0 + jnp.tanh(w_l) @ w2).astype(f32)) - 0.5
    decay = jnp.exp(-jnp.exp(w))
    a = jax.nn.sigmoid((a0 + a_l @ a2).astype(f32))
    g = jax.nn.sigmoid(g_l) @ g2

    def heads(t):
        return t.astype(f32).reshape(B, S, RWKV_HEADS, RWKV_HEAD)

    r, k, v, a, decay = heads(r), heads(k), heads(v), heads(a), heads(decay)
    kk = k * k_k.astype(f32).reshape(RWKV_HEADS, RWKV_HEAD)
    kk = kk / jnp.maximum(jnp.sqrt(jnp.sum(kk * kk, axis=-1, keepdims=True)), 1e-12)
    k = k * (1.0 + (a - 1.0) * k_a.astype(f32).reshape(RWKV_HEADS, RWKV_HEAD))
    xs = tuple(jnp.moveaxis(t, 1, 0) for t in (r, decay, k, v, -kk, kk * a))

    def step(state, inp):
        r_t, w_t, k_t, v_t, a_t, b_t = inp
        sa = jnp.einsum('bhvk,bhk->bhv', state, a_t)
        state = state * w_t[:, :, None, :] + sa[..., None] * b_t[:, :, None, :] + v_t[..., None] * k_t[:, :, None, :]
        return state, jnp.einsum('bhvk,bhk->bhv', state, r_t)

    state0 = jnp.zeros((B, RWKV_HEADS, RWKV_HEAD, RWKV_HEAD), f32)
    _, y = lax.scan(step, state0, xs)
    y = jnp.moveaxis(y, 0, 1)
    mean = jnp.mean(y, axis=-1, keepdims=True)
    var = jnp.mean((y - mean) ** 2, axis=-1, keepdims=True)
    y = ((y - mean) * lax.rsqrt(var + GN_EPS)).reshape(B, S, RWKV_W)
    y = y * gn_gain.astype(f32) + gn_bias.astype(f32)
    bonus = jnp.sum(r * k * r_k.astype(f32), axis=-1, keepdims=True) * v
    y = (y + bonus.reshape(B, S, RWKV_W)) * g.astype(f32)
    return y.astype(p.dtype)


def setup_inputs(seed: int = 0) -> dict:
    key = jax.random.key(seed)
    ks = jax.random.split(key, 40)
    cnt = [0]
    L = DEPTH

    def nxt():
        kk = ks[cnt[0]]
        cnt[0] += 1
        return kk

    def nrm(shape, scale):
        return jax.random.normal(nxt(), shape, jnp.float32) * scale

    def gain(shape):
        return 1.0 + nrm(shape, 0.05)

    def unif(shape, lo, hi):
        return jax.random.uniform(nxt(), shape, jnp.float32, lo, hi)

    return {
        'x': nrm((BATCH, SEQ, D_MODEL), 1.0),
        'ffn1_norm': gain((L, D_MODEL)),
        'ffn1_w_gate': nrm((L, D_MODEL, D_FF), D_MODEL ** -0.5),
        'ffn1_w_up': nrm((L, D_MODEL, D_FF), D_MODEL ** -0.5),
        'ffn1_w_down': nrm((L, D_FF, D_MODEL), D_FF ** -0.5),
        'mix_norm': gain((L, D_MODEL)),
        'w_in': nrm((L, D_MODEL, N_IN), D_MODEL ** -0.5),
        'q_lat_norm': gain((L, Q_LORA)),
        'w_q_up': nrm((L, Q_LORA, MLA_HEADS * MLA_QK), Q_LORA ** -0.5),
        'kv_lat_norm': gain((L, KV_LORA)),
        'w_kv_up': nrm((L, KV_LORA, MLA_HEADS * (MLA_NOPE + MLA_V)), KV_LORA ** -0.5),
        'q_norm': gain((L, MLA_QK)),
        'k_norm': gain((L, MLA_QK)),
        'shift_mu': unif((L, RWKV_IN), 0.0, 1.0),
        'w0': unif((L, RWKV_W), -4.0, 0.0),
        'w2': nrm((L, DECAY_LORA, RWKV_W), 0.5 * DECAY_LORA ** -0.5),
        'a0': nrm((L, RWKV_W), 0.1),
        'a2': nrm((L, A_LORA, RWKV_W), A_LORA ** -0.5),
        'g2': nrm((L, GATE_LORA, RWKV_W), GATE_LORA ** -0.5),
        'k_k': 0.85 + nrm((L, RWKV_W), 0.05),
        'k_a': gain((L, RWKV_W)),
        'r_k': nrm((L, RWKV_HEADS, RWKV_HEAD), 0.1),
        'gn_gain': gain((L, RWKV_W)),
        'gn_bias': nrm((L, RWKV_W), 0.02),
        'out_norm_mla': gain((L, MLA_W)),
        'out_norm_rwkv': gain((L, RWKV_W)),
        'w_out': nrm((L, MIX_W, D_MODEL), MIX_W ** -0.5),
        'ffn2_norm': gain((L, D_MODEL)),
        'ffn2_w_gate': nrm((L, D_MODEL, D_FF), D_MODEL ** -0.5),
        'ffn2_w_up': nrm((L, D_MODEL, D_FF), D_MODEL ** -0.5),
        'ffn2_w_down': nrm((L, D_FF, D_MODEL), D_FF ** -0.5),
    }


def reference(x, ffn1_norm, ffn1_w_gate, ffn1_w_up, ffn1_w_down, mix_norm, w_in,
              q_lat_norm, w_q_up, kv_lat_norm, w_kv_up, q_norm, k_norm,
              shift_mu, w0, w2, a0, a2, g2, k_k, k_a, r_k, gn_gain, gn_bias,
              out_norm_mla, out_norm_rwkv, w_out,
              ffn2_norm, ffn2_w_gate, ffn2_w_up, ffn2_w_down):
    S = x.shape[1]
    cos, sin = _rope_tables(S)
    for l in range(DEPTH):
        x = x + 0.5 * _swiglu(_rms_norm(x, ffn1_norm[l]), ffn1_w_gate[l], ffn1_w_up[l], ffn1_w_down[l])
        p = _rms_norm(x, mix_norm[l]) @ w_in[l]
        y_mla = _mla(p[..., :MLA_IN], q_lat_norm[l], w_q_up[l], kv_lat_norm[l], w_kv_up[l],
                     q_norm[l], k_norm[l], cos, sin)
        y_rwkv = _rwkv7(p[..., MLA_IN:], shift_mu[l], w0[l], w2[l], a0[l], a2[l], g2[l],
                        k_k[l], k_a[l], r_k[l], gn_gain[l], gn_bias[l])
        y = jnp.concatenate([_rms_norm(y_mla, out_norm_mla[l]), _rms_norm(y_rwkv, out_norm_rwkv[l])], axis=-1)
        x = x + y @ w_out[l]
        x = x + 0.5 * _swiglu(_rms_norm(x, ffn2_norm[l]), ffn2_w_gate[l], ffn2_w_up[l], ffn2_w_down[l])
    return x
```

```cpp
#include <hip/hip_runtime.h>
#include <cstdio>
#include <cstdint>
#include <cmath>
namespace pg8 {
#define PG8_LAS __attribute__((address_space(3)))
typedef unsigned short bf16_t;
typedef short bf16x8 __attribute__((ext_vector_type(8)));
typedef float f32x4 __attribute__((ext_vector_type(4)));
typedef unsigned u32x4 __attribute__((ext_vector_type(4)));
constexpr int BM = 256, BK = 64, HALF = 128, HTB = HALF * BK * 2  , STAGE_BYTES = 8 * HTB, NXCD = 8, WGM = 8;

__host__ __device__ __forceinline__ int lds_byte(int r, int c) { const int st = (r >> 4) * 2 + (c >> 5), rr = r & 15, cc = c & 31, ob = rr * 64 + cc * 2; return st * 1024 + (ob ^ (((ob >> 9) & 1) << 5)); }
__host__ __device__ __forceinline__ void stage_rc(int b, int& R, int& C) { const int st = b / 1024, sb = b % 1024, swz = sb ^ (((sb >> 9) & 1) << 5); R = (st >> 1) * 16 + swz / 64; C = (st & 1) * 32 + (swz % 64) / 2; }
__host__ __device__ __forceinline__ int perm32(int rho) { const int n = rho >> 4, i = rho & 15; return 8 * (i >> 2) + 4 * n + (i & 3); }

struct Unit { int pm, pn; };
struct Gemm { const bf16_t* A; const bf16_t* Bt; int M, N, K, lda, ldb; };

struct StaticOrder {
    int nM, nN, nwg, G, c;
    __host__ __device__ __forceinline__ void init(int M, int N, int G_, int c_) { nM = M / BM; nN = N / BM; nwg = nM * nN; G = G_; c = c_; }
    __host__ __device__ __forceinline__ bool next(int i, Unit& u) const {
        const long L = (long)i * G + c; if (L >= nwg) return false;
        int wgid = (int)L; { const int q = nwg / NXCD, r = nwg % NXCD, xcd = wgid % NXCD, off = wgid / NXCD; wgid = (xcd < r ? xcd * (q + 1) : r * (q + 1) + (xcd - r) * q) + off; }
        const int nig = WGM * nN, gid = wgid / nig, fm = gid * WGM, gsz = (nM - fm) < WGM ? (nM - fm) : WGM;
        u.pm = fm + ((wgid % nig) % gsz); u.pn = (wgid % nig) / gsz; return true;
    }
    __device__ __forceinline__ void a_ready(const Unit&) const {}
    __device__ __forceinline__ void done(const Unit&) const {}
};
typedef __bf16 pg8_nbf16x2_t __attribute__((ext_vector_type(2)));
typedef float pg8_nf32x2_t __attribute__((ext_vector_type(2)));
__device__ __forceinline__ unsigned cvt_pk_bf16(float lo, float hi) { return __builtin_bit_cast(unsigned, __builtin_convertvector((pg8_nf32x2_t){lo, hi}, pg8_nbf16x2_t)); }
typedef float f32x2 __attribute__((ext_vector_type(2)));
typedef unsigned u32x2 __attribute__((ext_vector_type(2)));
template <int K> __device__ __forceinline__ float swz_xor(float v) { return __builtin_bit_cast(float, __builtin_amdgcn_ds_swizzle(__builtin_bit_cast(int, v), (K << 10) | 0x1f)); }
template <int CTRL> __device__ __forceinline__ float dpp_mov(float v) { return __builtin_bit_cast(float, __builtin_amdgcn_update_dpp(0, __builtin_bit_cast(int, v), CTRL, 0xf, 0xf, false)); }
__device__ __forceinline__ float row16_sum(float v) { v += dpp_mov<0x128>(v); v += dpp_mov<0x124>(v); v += dpp_mov<0x122>(v); v += dpp_mov<0x121>(v); return v; }
__device__ __forceinline__ float oct_sum(float v) { v += dpp_mov<0xB1>(v); v += dpp_mov<0x4E>(v); v += dpp_mov<0x141>(v); return v; }
__device__ __forceinline__ void x32_pair(float v, float& a, float& b) {
    unsigned u0 = __builtin_bit_cast(unsigned, v), u1 = u0; asm volatile("" : "+v"(u1));
    const auto rr = __builtin_amdgcn_permlane32_swap(u0, u1, false, false);
    unsigned r0 = rr[0], r1 = rr[1]; asm volatile("" : "+v"(r0), "+v"(r1));
    a = __builtin_bit_cast(float, r0); b = __builtin_bit_cast(float, r1);
}
__device__ __forceinline__ float sum_x32(float v) { float a, b; x32_pair(v, a, b); return a + b; }
__device__ __forceinline__ float max_x32(float v) { float a, b; x32_pair(v, a, b); return fmaxf(a, b); }
__device__ __forceinline__ float row_rstd(const float* rss, int row, int fq) {
    const f32x4 v = *(const f32x4*)(rss + (size_t)row * 16 + 4 * fq);
    float s = (v[0] + v[1]) + (v[2] + v[3]);
    s += swz_xor<16>(s); s = sum_x32(s);
    return rsqrtf(s * (1.0f / 1024.0f) + 1e-6f);
}
__device__ __forceinline__ float row_rstd_v(const f32x4 v) {
    float s = (v[0] + v[1]) + (v[2] + v[3]);
    s += swz_xor<16>(s); s = sum_x32(s);
    return rsqrtf(s * (1.0f / 1024.0f) + 1e-6f);
}
__device__ __forceinline__ float silu_mul(float g, float u) { return g * __builtin_amdgcn_rcpf(1.0f + __expf(-g)) * u; }
struct EpiSwiGLU {
    static constexpr bool PERM = true, AFTER_DRAIN = false, MID = false;
    bf16_t* H; const float* rss; int ldh;
    __device__ __forceinline__ void operator()(const f32x4 (&acc)[2][2][4][2], const Unit& u, int wr, int wc, int fr_in, int fq_in) const {
        int ln_; asm volatile("v_mbcnt_lo_u32_b32 %0, -1, 0\n\tv_mbcnt_hi_u32_b32 %0, -1, %0" : "=v"(ln_)); const int fr = ln_ & 15, fq = ln_ >> 4; (void)fr_in; (void)fq_in;
        const int col0 = u.pn * 128 + wc * 32 + 8 * fq;
        f32x4 pv[2][4];
#pragma unroll
        for (int ai = 0; ai < 2; ++ai)
#pragma unroll
            for (int m = 0; m < 4; ++m) pv[ai][m] = *(const f32x4*)(rss + (size_t)(u.pm * BM + ai * HALF + wr * 64 + m * 16 + fr) * 16 + 4 * fq);
        asm volatile("" ::: "memory");
#pragma unroll
        for (int ai = 0; ai < 2; ++ai)
#pragma unroll
            for (int m = 0; m < 4; ++m) {
                const int row = u.pm * BM + ai * HALF + wr * 64 + m * 16 + fr;
                const float rs = row_rstd_v(pv[ai][m]);
                const float s2 = rs * -1.4426950408889634f, rs2 = rs * rs;
                const f32x4 t0 = acc[ai][0][m][0] * s2, t1 = acc[ai][0][m][1] * s2;
                float e[8], r[8];
#pragma unroll
                for (int j = 0; j < 4; ++j) { e[j] = __builtin_amdgcn_exp2f(t0[j]); e[4 + j] = __builtin_amdgcn_exp2f(t1[j]); }
#pragma unroll
                for (int j = 0; j < 8; ++j) r[j] = __builtin_amdgcn_rcpf(1.0f + e[j]);
                const f32x4 h0 = (acc[ai][0][m][0] * acc[ai][1][m][0]) * rs2, h1 = (acc[ai][0][m][1] * acc[ai][1][m][1]) * rs2;
                u32x4 w;
                w.x = cvt_pk_bf16(h0[0] * r[0], h0[1] * r[1]);
                w.y = cvt_pk_bf16(h0[2] * r[2], h0[3] * r[3]);
                w.z = cvt_pk_bf16(h1[0] * r[4], h1[1] * r[5]);
                w.w = cvt_pk_bf16(h1[2] * r[6], h1[3] * r[7]);
                *(u32x4*)(H + (size_t)row * ldh + col0) = w;
                asm volatile("" ::: "memory");
            }
    }
};
template <bool WRITE_XB> struct EpiResidT {
    static constexpr bool PERM = true, AFTER_DRAIN = false, MID = false;
    float* X; bf16_t* XB; float* rss; float alpha; const float* ss;
    __device__ __forceinline__ void operator()(const f32x4 (&acc)[2][2][4][2], const Unit& u, int wr, int wc, int fr_in, int fq_in) const {
        int ln_; asm volatile("v_mbcnt_lo_u32_b32 %0, -1, 0\n\tv_mbcnt_hi_u32_b32 %0, -1, %0" : "=v"(ln_)); const int fr = ln_ & 15, fq = ln_ >> 4; (void)fr_in; (void)fq_in;
        const int col0 = u.pn * BM + wc * 32 + 8 * fq;
#pragma unroll
        for (int ai = 0; ai < 2; ++ai)
#pragma unroll
            for (int m = 0; m < 4; ++m) {
                const int row = u.pm * BM + ai * HALF + wr * 64 + m * 16 + fr;
                float sc = alpha;
                if (ss) { const f32x4 pv = *(const f32x4*)(ss + (size_t)row * 8 + 4 * (fq & 1)); float t = (pv[0] + pv[1]) + (pv[2] + pv[3]); t += swz_xor<16>(t); sc = alpha * rsqrtf(t * (1.0f / 512.0f) + 1e-6f); }
                float sq = 0.f;
#pragma unroll
                for (int bj = 0; bj < 2; ++bj) {
                    const size_t off = (size_t)row * 1024 + col0 + bj * HALF;
                    const u32x4 xr = *(const u32x4*)(XB + off);
                    f32x4 x0, x1;
                    x0[0] = __builtin_bit_cast(float, xr.x << 16); x0[1] = __builtin_bit_cast(float, xr.x & 0xffff0000u); x0[2] = __builtin_bit_cast(float, xr.y << 16); x0[3] = __builtin_bit_cast(float, xr.y & 0xffff0000u);
                    x1[0] = __builtin_bit_cast(float, xr.z << 16); x1[1] = __builtin_bit_cast(float, xr.z & 0xffff0000u); x1[2] = __builtin_bit_cast(float, xr.w << 16); x1[3] = __builtin_bit_cast(float, xr.w & 0xffff0000u);
                    x0 = x0 + acc[ai][bj][m][0] * sc; x1 = x1 + acc[ai][bj][m][1] * sc;
                    if (X) { *(f32x4*)(X + off) = x0; *(f32x4*)(X + off + 4) = x1; }
                    if (WRITE_XB) { u32x4 w; w.x = cvt_pk_bf16(x0[0], x0[1]); w.y = cvt_pk_bf16(x0[2], x0[3]); w.z = cvt_pk_bf16(x1[0], x1[1]); w.w = cvt_pk_bf16(x1[2], x1[3]); *(u32x4*)(XB + off) = w;
                        sq += ((x0[0] * x0[0] + x0[1] * x0[1]) + (x0[2] * x0[2] + x0[3] * x0[3])) + ((x1[0] * x1[0] + x1[1] * x1[1]) + (x1[2] * x1[2] + x1[3] * x1[3])); }
                }
                if (WRITE_XB) { sq += swz_xor<16>(sq); sq = sum_x32(sq); if (fq == 0) rss[(size_t)row * 16 + u.pn * 4 + wc] = sq; }
                if (m & 1) asm volatile("" ::: "memory");
            }
    }
};
typedef EpiResidT<true> EpiResid;
struct EpiResidMid {
    static constexpr bool PERM = true, AFTER_DRAIN = false, MID = true;
    float* X; bf16_t* XB; float* rss; const PG8_LAS float* tab;
    __device__ __forceinline__ void mid(f32x4 (&acc)[2][2][4][2], int wr) const {
        int ln_; asm volatile("v_mbcnt_lo_u32_b32 %0, -1, 0\n\tv_mbcnt_hi_u32_b32 %0, -1, %0" : "=v"(ln_)); const int fr = ln_ & 15;
#pragma unroll
        for (int ai = 0; ai < 2; ++ai)
#pragma unroll
            for (int m = 0; m < 4; ++m) { const float r = tab[2 * (ai * HALF + wr * 64 + m * 16 + fr)];
#pragma unroll
                for (int bj = 0; bj < 2; ++bj)
#pragma unroll
                    for (int n = 0; n < 2; ++n) acc[ai][bj][m][n] = acc[ai][bj][m][n] * r; }
    }
    __device__ __forceinline__ void operator()(const f32x4 (&acc)[2][2][4][2], const Unit& u, int wr, int wc, int fr_in, int fq_in) const {
        int ln_; asm volatile("v_mbcnt_lo_u32_b32 %0, -1, 0\n\tv_mbcnt_hi_u32_b32 %0, -1, %0" : "=v"(ln_)); const int fr = ln_ & 15, fq = ln_ >> 4; (void)fr_in; (void)fq_in;
#pragma unroll
        for (int ai = 0; ai < 2; ++ai)
#pragma unroll
            for (int m = 0; m < 4; ++m) {
                const int lr = ai * HALF + wr * 64 + m * 16 + fr, row = u.pm * BM + lr;
                const float sc = tab[2 * lr + 1];
                float sq = 0.f;
#pragma unroll
                for (int bj = 0; bj < 2; ++bj) {
                    const size_t off = (size_t)row * 1024 + u.pn * BM + wc * 32 + 8 * fq + bj * HALF;
                    const u32x4 xr = *(const u32x4*)(XB + off);
                    f32x4 x0, x1;
                    x0[0] = __builtin_bit_cast(float, xr.x << 16); x0[1] = __builtin_bit_cast(float, xr.x & 0xffff0000u); x0[2] = __builtin_bit_cast(float, xr.y << 16); x0[3] = __builtin_bit_cast(float, xr.y & 0xffff0000u);
                    x1[0] = __builtin_bit_cast(float, xr.z << 16); x1[1] = __builtin_bit_cast(float, xr.z & 0xffff0000u); x1[2] = __builtin_bit_cast(float, xr.w << 16); x1[3] = __builtin_bit_cast(float, xr.w & 0xffff0000u);
                    x0 = x0 + acc[ai][bj][m][0] * sc; x1 = x1 + acc[ai][bj][m][1] * sc;
                    u32x4 w; w.x = cvt_pk_bf16(x0[0], x0[1]); w.y = cvt_pk_bf16(x0[2], x0[3]); w.z = cvt_pk_bf16(x1[0], x1[1]); w.w = cvt_pk_bf16(x1[2], x1[3]); *(u32x4*)(XB + off) = w;
                    sq += ((x0[0] * x0[0] + x0[1] * x0[1]) + (x0[2] * x0[2] + x0[3] * x0[3])) + ((x1[0] * x1[0] + x1[1] * x1[1]) + (x1[2] * x1[2] + x1[3] * x1[3]));
                }
                sq += swz_xor<16>(sq); sq = sum_x32(sq); if (fq == 0) rss[(size_t)row * 16 + u.pn * 4 + wc] = sq;
                if (m & 1) asm volatile("" ::: "memory");
            }
    }
};
struct EpiStore {
    static constexpr bool PERM = true, AFTER_DRAIN = false, MID = false;
    bf16_t* O; int ldc; const float* rss;
    __device__ __forceinline__ void operator()(const f32x4 (&acc)[2][2][4][2], const Unit& u, int wr, int wc, int fr_in, int fq_in) const {
        int ln_; asm volatile("v_mbcnt_lo_u32_b32 %0, -1, 0\n\tv_mbcnt_hi_u32_b32 %0, -1, %0" : "=v"(ln_)); const int fr = ln_ & 15, fq = ln_ >> 4; (void)fr_in; (void)fq_in;
        const int col0 = u.pn * BM + wc * 32 + 8 * fq;
        f32x4 pv[2][4];
#pragma unroll
        for (int ai = 0; ai < 2; ++ai)
#pragma unroll
            for (int m = 0; m < 4; ++m) pv[ai][m] = rss ? *(const f32x4*)(rss + (size_t)(u.pm * BM + ai * HALF + wr * 64 + m * 16 + fr) * 16 + 4 * fq) : (f32x4){0.f, 0.f, 0.f, 0.f};
        asm volatile("" ::: "memory");
#pragma unroll
        for (int ai = 0; ai < 2; ++ai)
#pragma unroll
            for (int m = 0; m < 4; ++m) {
                const int row = u.pm * BM + ai * HALF + wr * 64 + m * 16 + fr;
                const float rs = rss ? row_rstd_v(pv[ai][m]) : 1.0f;
#pragma unroll
                for (int bj = 0; bj < 2; ++bj) {
                    const f32x4 v0 = acc[ai][bj][m][0] * rs, v1 = acc[ai][bj][m][1] * rs;
                    u32x4 w; w.x = cvt_pk_bf16(v0[0], v0[1]); w.y = cvt_pk_bf16(v0[2], v0[3]); w.z = cvt_pk_bf16(v1[0], v1[1]); w.w = cvt_pk_bf16(v1[2], v1[3]);
                    *(u32x4*)(O + (size_t)row * ldc + col0 + bj * HALF) = w;
                }
                asm volatile("" ::: "memory");
            }
    }
};
struct EpiLora {
    static constexpr bool PERM = true, AFTER_DRAIN = false, MID = false;
    float* DEC; bf16_t* AS; bf16_t* G; const float* w0; const float* a0;
    __device__ __forceinline__ void operator()(const f32x4 (&acc)[2][2][4][2], const Unit& u, int wr, int wc, int fr_in, int fq_in) const {
        int ln_; asm volatile("v_mbcnt_lo_u32_b32 %0, -1, 0\n\tv_mbcnt_hi_u32_b32 %0, -1, %0" : "=v"(ln_)); const int fr = ln_ & 15, fq = ln_ >> 4; (void)fr_in; (void)fq_in;
        const int which = u.pn >> 1, cb = (u.pn & 1) * BM + wc * 32 + 8 * fq;
        const float* bias = (which == 0) ? w0 : a0; const float bsc = (which == 2) ? 0.f : 1.f;
        bf16_t* ob = (which == 1) ? AS : G;
#pragma unroll
        for (int ai = 0; ai < 2; ++ai)
#pragma unroll
            for (int m = 0; m < 4; ++m) {
                const int row = u.pm * BM + ai * HALF + wr * 64 + m * 16 + fr;
#pragma unroll
                for (int bj = 0; bj < 2; ++bj) {
                    const size_t off = (size_t)row * 512 + cb + bj * HALF;
                    const float* bp = bias + cb + bj * HALF;
                    f32x4 v0 = acc[ai][bj][m][0] + *(const f32x4*)bp * bsc, v1 = acc[ai][bj][m][1] + *(const f32x4*)(bp + 4) * bsc;
                    f32x4 s0, s1, d0, d1;
#pragma unroll
                    for (int e = 0; e < 4; ++e) { s0[e] = __builtin_amdgcn_rcpf(1.0f + __expf(-v0[e])); s1[e] = __builtin_amdgcn_rcpf(1.0f + __expf(-v1[e])); d0[e] = -0.60653065971f * s0[e]; d1[e] = -0.60653065971f * s1[e]; }
                    if (which == 0) { *(f32x4*)(DEC + off) = d0; *(f32x4*)(DEC + off + 4) = d1; }
                    else {
                        if (which == 1) { v0 = s0; v1 = s1; }
                        u32x4 w; w.x = cvt_pk_bf16(v0[0], v0[1]); w.y = cvt_pk_bf16(v0[2], v0[3]); w.z = cvt_pk_bf16(v1[0], v1[1]); w.w = cvt_pk_bf16(v1[2], v1[3]);
                        *(u32x4*)(ob + off) = w;
                    }
                }
                asm volatile("" ::: "memory");
            }
    }
};
template <class Epi, class Sched, bool ALIGN_EPI = false, bool SP2 = false>
__device__ __forceinline__ void gemm_phase(PG8_LAS unsigned char* lds, const Gemm g, const Sched& S, const Epi& E, const int wid_in  ) {
    int lane_; asm volatile("v_mbcnt_lo_u32_b32 %0, -1, 0\n\tv_mbcnt_hi_u32_b32 %0, -1, %0" : "=v"(lane_));
    int wid_ = wid_in; asm volatile("" : "+s"(wid_));
    const int wid = wid_, lane = lane_, tid = wid * 64 + lane, wr = wid >> 2, wc = wid & 3, fr = lane & 15, fq = lane >> 4;
    const int K = g.K, nt = K / BK;
    unsigned voffA[2], voffB[2];
#pragma unroll
    for (int i = 0; i < 2; ++i) { int R, C; stage_rc(tid * 16 + i * 8192, R, C); const int Rb = Epi::PERM ? ((R & ~31) + perm32(R & 31)) : R;
        voffA[i] = (unsigned)(R * g.lda + C) * 2u; voffB[i] = (unsigned)(Rb * g.ldb + C) * 2u; }
    const size_t kstep = (size_t)(BK * 2);
    const size_t hstepA = (size_t)HALF * g.lda * 2, hstepB = (size_t)HALF * g.ldb * 2;
    const size_t tstepA = 2 * hstepA, tstepB = 2 * hstepB;
    const unsigned ldsw = (unsigned)wid * 1024u;
    const int aoff = lds_byte(wr * 64 + fr, fq * 8), boff = lds_byte(wc * 32 + fr, fq * 8);
#define PG8_SA(b, h) (((b) * 2 + (h)) * HTB)
#define PG8_SB(b, h) ((4 + (b) * 2 + (h)) * HTB)
#define PG8_STAGE(bufoff, gbase, voff) do { _Pragma("unroll") for (int _i = 0; _i < 2; ++_i) \
        __builtin_amdgcn_global_load_lds((const unsigned*)((const char*)(gbase) + (voff)[_i]), (PG8_LAS unsigned*)(lds + (bufoff) + ldsw + _i * 8192), 16, 0, 0); } while (0)
#define PG8_LDA(dst, b, h) do { _Pragma("unroll") for (int m = 0; m < 4; ++m) _Pragma("unroll") for (int k = 0; k < 2; ++k) dst[m][k] = *(const PG8_LAS bf16x8*)(lds + PG8_SA(b, h) + aoff + m * 2048 + k * 1024); } while (0)
#define PG8_LDB(dst, b, h) do { _Pragma("unroll") for (int n = 0; n < 2; ++n) _Pragma("unroll") for (int k = 0; k < 2; ++k) dst[n][k] = *(const PG8_LAS bf16x8*)(lds + PG8_SB(b, h) + boff + n * 2048 + k * 1024); } while (0)
#define PG8_MMA(ai, bj, At, Bt) do { __builtin_amdgcn_s_setprio(1); _Pragma("unroll") for (int m = 0; m < 4; ++m) _Pragma("unroll") for (int n = 0; n < 2; ++n) _Pragma("unroll") for (int k = 0; k < 2; ++k) \
        acc[ai][bj][m][n] = __builtin_amdgcn_mfma_f32_16x16x32_bf16(Bt[n][k], At[m][k], acc[ai][bj][m][n], 0, 0, 0); __builtin_amdgcn_s_setprio(0); } while (0)
#define PG8_WAIT_V(n) asm volatile("s_waitcnt vmcnt(" #n ")" ::: "memory")
#define PG8_WAIT_L(n) asm volatile("s_waitcnt lgkmcnt(" #n ")" ::: "memory")
#define PG8_BAR __builtin_amdgcn_s_barrier()
#define PG8_SCHED __builtin_amdgcn_sched_barrier(0)
    Unit cur, nxt; int ui = 0;
    if (!S.next(0, cur)) return;
    f32x4 acc[2][2][4][2];
#pragma unroll
    for (int a = 0; a < 2; ++a)
#pragma unroll
        for (int b = 0; b < 2; ++b)
#pragma unroll
            for (int m = 0; m < 4; ++m)
#pragma unroll
                for (int n = 0; n < 2; ++n) acc[a][b][m][n] = (f32x4){0.f, 0.f, 0.f, 0.f};
    bf16x8 At[4][2], B0[2][2], B1[2][2];
    const char* cA = (const char*)g.A + (size_t)cur.pm * tstepA; const char* cB = (const char*)g.Bt + (size_t)cur.pn * tstepB;
    S.a_ready(cur);
    if constexpr (SP2) {
        PG8_STAGE(PG8_SB(0, 0), cB, voffB); PG8_STAGE(PG8_SB(0, 1), cB + hstepB, voffB); PG8_STAGE(PG8_SA(0, 0), cA, voffA); PG8_STAGE(PG8_SA(0, 1), cA + hstepA, voffA);
        if (wr == 1) PG8_BAR;
        PG8_WAIT_V(2); PG8_BAR;
        PG8_STAGE(PG8_SB(1, 0), cB + kstep, voffB); PG8_STAGE(PG8_SA(1, 0), cA + kstep, voffA); PG8_STAGE(PG8_SB(1, 1), cB + hstepB + kstep, voffB);
        PG8_WAIT_V(6); PG8_BAR;
    } else {
        PG8_STAGE(PG8_SB(0, 0), cB, voffB); PG8_STAGE(PG8_SA(0, 0), cA, voffA); PG8_STAGE(PG8_SB(0, 1), cB + hstepB, voffB); PG8_STAGE(PG8_SA(0, 1), cA + hstepA, voffA);
        if (wr == 1) PG8_BAR;
        PG8_WAIT_V(4); PG8_BAR;
        PG8_STAGE(PG8_SB(1, 0), cB + kstep, voffB); PG8_STAGE(PG8_SA(1, 0), cA + kstep, voffA); PG8_STAGE(PG8_SB(1, 1), cB + hstepB + kstep, voffB);
        PG8_WAIT_V(6); PG8_BAR;
    }
    for (;;) {
        const bool has_next = S.next(ui + 1, nxt);
        const char* nA = has_next ? (const char*)g.A + (size_t)nxt.pm * tstepA : cA; const char* nB = has_next ? (const char*)g.Bt + (size_t)nxt.pn * tstepB : cB;
        for (int th = 0; th < (Epi::MID ? 2 : 1); ++th) {
        if constexpr (Epi::MID) { if (th == 1) E.mid(acc, wr); }
        const int t_lo = Epi::MID ? th * (nt >> 1) : 0, t_hi = Epi::MID ? (th + 1) * (nt >> 1) : nt;
        for (int t = t_lo; t < t_hi; t += 2) {
            const bool last = (t == nt - 2);
            const char* a1 = cA + (size_t)(t + 1) * kstep;
            const char* a2 = last ? nA : cA + (size_t)(t + 2) * kstep; const char* b2 = last ? nB : cB + (size_t)(t + 2) * kstep;
            const char* a3 = a2 + kstep; const char* b3 = b2 + kstep;
            if (last && has_next) S.a_ready(nxt);
            if constexpr (SP2) {
            PG8_LDB(B0, 0, 0); PG8_LDB(B1, 0, 1); PG8_SCHED; PG8_LDA(At, 0, 0); PG8_STAGE(PG8_SA(1, 1), a1 + hstepA, voffA);
            PG8_WAIT_V(8); PG8_WAIT_L(0); PG8_BAR; PG8_MMA(0, 0, At, B0); PG8_MMA(0, 1, At, B1); PG8_BAR; PG8_SCHED;
            PG8_LDA(At, 0, 1); PG8_STAGE(PG8_SB(0, 0), b2, voffB); PG8_STAGE(PG8_SB(0, 1), b2 + hstepB, voffB); PG8_STAGE(PG8_SA(0, 0), a2, voffA);
            PG8_WAIT_V(8); PG8_WAIT_L(0); PG8_BAR; PG8_MMA(1, 0, At, B0); PG8_MMA(1, 1, At, B1); PG8_BAR; PG8_SCHED;
            PG8_LDB(B0, 1, 0); PG8_LDB(B1, 1, 1); PG8_SCHED; PG8_LDA(At, 1, 0); PG8_STAGE(PG8_SA(0, 1), a2 + hstepA, voffA);
            PG8_WAIT_V(8); PG8_WAIT_L(0); PG8_BAR; PG8_MMA(0, 0, At, B0); PG8_MMA(0, 1, At, B1); PG8_BAR; PG8_SCHED;
            PG8_LDA(At, 1, 1); PG8_STAGE(PG8_SB(1, 0), b3, voffB); PG8_STAGE(PG8_SB(1, 1), b3 + hstepB, voffB); PG8_STAGE(PG8_SA(1, 0), a3, voffA);
            PG8_WAIT_V(8); PG8_WAIT_L(0); PG8_BAR; PG8_MMA(1, 0, At, B0); PG8_MMA(1, 1, At, B1); PG8_BAR; PG8_SCHED;
            } else {
            PG8_LDB(B0, 0, 0); PG8_SCHED; PG8_LDA(At, 0, 0); PG8_STAGE(PG8_SA(1, 1), a1 + hstepA, voffA);
            PG8_WAIT_L(8); PG8_BAR; PG8_WAIT_L(0); PG8_MMA(0, 0, At, B0); PG8_BAR; PG8_SCHED;
            PG8_LDB(B1, 0, 1); PG8_STAGE(PG8_SB(0, 0), b2, voffB);
            PG8_BAR; PG8_WAIT_L(0); PG8_MMA(0, 1, At, B1); PG8_BAR;
            PG8_LDA(At, 0, 1); PG8_STAGE(PG8_SA(0, 0), a2, voffA);
            PG8_BAR; PG8_WAIT_L(0); PG8_MMA(1, 0, At, B0); PG8_BAR; PG8_SCHED;
            PG8_STAGE(PG8_SB(0, 1), b2 + hstepB, voffB);
            PG8_WAIT_V(6); PG8_BAR; PG8_MMA(1, 1, At, B1); PG8_BAR;
            PG8_LDB(B0, 1, 0); PG8_SCHED; PG8_LDA(At, 1, 0); PG8_STAGE(PG8_SA(0, 1), a2 + hstepA, voffA);
            PG8_WAIT_L(8); PG8_BAR; PG8_WAIT_L(0); PG8_MMA(0, 0, At, B0); PG8_BAR; PG8_SCHED;
            PG8_LDB(B1, 1, 1); PG8_STAGE(PG8_SB(1, 0), b3, voffB);
            PG8_BAR; PG8_WAIT_L(0); PG8_MMA(0, 1, At, B1); PG8_BAR;
            PG8_LDA(At, 1, 1); PG8_STAGE(PG8_SA(1, 0), a3, voffA);
            PG8_BAR; PG8_WAIT_L(0); PG8_MMA(1, 0, At, B0); PG8_BAR; PG8_SCHED;
            PG8_STAGE(PG8_SB(1, 1), b3 + hstepB, voffB);
            PG8_WAIT_V(6); PG8_BAR; PG8_MMA(1, 1, At, B1); PG8_BAR;
            }
        }
        }
        if constexpr (ALIGN_EPI) { if (wr == 0) PG8_BAR; }
        if constexpr (!Epi::AFTER_DRAIN) { E(acc, cur, wr, wc, fr, fq); S.done(cur); }
        if (!has_next) break;
#pragma unroll
        for (int a = 0; a < 2; ++a)
#pragma unroll
            for (int b = 0; b < 2; ++b)
#pragma unroll
                for (int m = 0; m < 4; ++m)
#pragma unroll
                    for (int n = 0; n < 2; ++n) acc[a][b][m][n] = (f32x4){0.f, 0.f, 0.f, 0.f};
        cur = nxt; cA = nA; cB = nB; ++ui;
        if constexpr (ALIGN_EPI) { if (wr == 1) PG8_BAR; }
    }
    PG8_WAIT_V(0);
    if constexpr (!ALIGN_EPI) { if (wr == 0) PG8_BAR; }
    PG8_BAR;
    if constexpr (Epi::AFTER_DRAIN) { E.fused(acc, cur, wr, wc, fr, fq, lds, wid, lane); S.done(cur); }
#undef PG8_SA
#undef PG8_SB
#undef PG8_STAGE
#undef PG8_LDA
#undef PG8_LDB
#undef PG8_MMA
#undef PG8_WAIT_V
#undef PG8_WAIT_L
#undef PG8_BAR
#undef PG8_SCHED
}
}

constexpr int NWAVES = 8;
constexpr int NB = 4, SEQ = 4096, DM = 1024, DFF = 2816, NLAYER = 4;
constexpr int MTOK = NB * SEQ;
constexpr int NIN = 2240, NINP = 2304;
constexpr int NHEAD = 8, DQK = 96, DV = 64;
constexpr float EPS = 1e-6f;
constexpr int RW_OFF = 416;
constexpr size_t MiB = 1u << 20;
constexpr size_t WS_CTL = 0, CTL_ZERO_BYTES = 32 * 1024;
constexpr size_t WS_RSS = 1 * MiB;
constexpr size_t WS_WGU1 = 2 * MiB, WS_WDN1 = 13 * MiB, WS_WGU2 = 19 * MiB, WS_WDN2 = 30 * MiB, WS_WIN = 36 * MiB, WS_WOUT = 41 * MiB;
constexpr size_t WS_WQ = 43 * MiB, WS_WKV = WS_WQ + 512 * 1024, WS_WLORA = 44 * MiB;
constexpr size_t WS_XB = 46 * MiB;
constexpr size_t R1 = 78 * MiB;
constexpr size_t WS_HB = R1;
constexpr size_t WS_P = R1;
constexpr size_t WS_QLN = R1 + 72 * MiB, WS_KVLN = R1 + 80 * MiB, WS_LA = R1 + 88 * MiB;
constexpr size_t WS_K = R1 + 72 * MiB;
constexpr size_t WS_AS = R1 + 100 * MiB;
constexpr size_t WS_DEC = R1 + 116 * MiB;
constexpr size_t WS_SHS = R1 + 116 * MiB;
constexpr size_t WS_G = R1 + 148 * MiB;
constexpr size_t WS_QRAW = R1 + 164 * MiB, WS_KVRAW = R1 + 188 * MiB;
constexpr size_t WS_SP = R1 + 164 * MiB, WS_SQT = R1 + 180 * MiB, WS_SRH = R1 + 196 * MiB, WS_SYVT = R1 + 212 * MiB;
constexpr size_t WS_Q = R1 + 228 * MiB, WS_V = R1 + 252 * MiB;
constexpr size_t WS_YN = R1 + 268 * MiB;
constexpr size_t WS_KPE = R1 + 300 * MiB;
constexpr size_t WS_KN = R1 + 301 * MiB + 1536 * 1024;
constexpr size_t WS_BS = R1 + 301 * MiB, WS_SSA = WS_BS + 512 * 1024, WS_SSR = WS_BS + 1024 * 1024;
constexpr size_t WS_END = R1 + 303 * MiB;
constexpr size_t WS_ROPE = 512 * 1024;
constexpr int RING_BYTES = 131072;
constexpr int MISC_OFF = RING_BYTES + 320;
constexpr int LDS_BYTES = 147456;

#define GAS __attribute__((address_space(1)))
#define LAS __attribute__((address_space(3)))
typedef unsigned short bf16;
typedef unsigned v4u __attribute__((ext_vector_type(4)));
typedef unsigned v2u __attribute__((ext_vector_type(2)));
typedef float f32x4 __attribute__((ext_vector_type(4)));
typedef float f32x16 __attribute__((ext_vector_type(16)));
typedef short bf16x8 __attribute__((ext_vector_type(8)));
typedef short s16x4 __attribute__((ext_vector_type(4)));
typedef GAS unsigned gu32;
#define RLX_AGENT __ATOMIC_RELAXED, __HIP_MEMORY_SCOPE_AGENT
#define LDS_WAIT() asm volatile("s_waitcnt lgkmcnt(0)" ::: "memory")
typedef __bf16 nbf16x2_t __attribute__((ext_vector_type(2)));
typedef float nf32x2_t __attribute__((ext_vector_type(2)));
__device__ __forceinline__ unsigned pk2(float lo, float hi) { return __builtin_bit_cast(unsigned, __builtin_convertvector((nf32x2_t){lo, hi}, nbf16x2_t)); }
__device__ __forceinline__ unsigned f2bf(float f) { return (unsigned)__builtin_bit_cast(unsigned short, (__bf16)f); }
__device__ __forceinline__ float bf2f(unsigned short b) { return __builtin_bit_cast(float, (unsigned)b << 16); }
__device__ __forceinline__ float bflo(unsigned w) { return __builtin_bit_cast(float, w << 16); }
__device__ __forceinline__ float bfhi(unsigned w) { return __builtin_bit_cast(float, w & 0xffff0000u); }
__device__ __forceinline__ float wave_sum(float v) {
    v = pg8::row16_sum(v);
    const int u = __builtin_bit_cast(int, v);
    const float a = __builtin_bit_cast(float, __builtin_amdgcn_readlane(u, 0)), b = __builtin_bit_cast(float, __builtin_amdgcn_readlane(u, 16));
    const float c = __builtin_bit_cast(float, __builtin_amdgcn_readlane(u, 32)), d = __builtin_bit_cast(float, __builtin_amdgcn_readlane(u, 48));
    return (a + b) + (c + d);
}
#define XB_TMO      128
#define XB_XCNT(j)  (256  + 64 * (j))
#define XB_XSUB(j)  (1280 + 64 * (j))
#define XB_XGEN(j)  (2304 + 64 * (j))
#define XB_TOP      3328
#define XB_TOPGEN   3392
#define XCD_BAR_WORDS 3456
#define XB_SPIN_CAP (1u << 21)

__device__ __forceinline__ unsigned xb_ld(unsigned* p)              { return __hip_atomic_load(p, __ATOMIC_RELAXED, __HIP_MEMORY_SCOPE_AGENT); }
__device__ __forceinline__ unsigned xb_add(unsigned* p, unsigned v) { return __hip_atomic_fetch_add(p, v, __ATOMIC_RELAXED, __HIP_MEMORY_SCOPE_AGENT); }
__device__ __forceinline__ unsigned xb_xcc_id() { return (unsigned)__builtin_amdgcn_s_getreg((3 << 11) | 20) & 0xFu; }
#define XB_SPIN(cond, bar) do { unsigned _sp = 0; while (cond) { __builtin_amdgcn_s_sleep(1); \
    if ((++_sp & 255u) == 0u) { if (xb_ld(&(bar)[XB_TMO])) break; if (_sp > XB_SPIN_CAP) { atomicAdd(&(bar)[XB_TMO], 1u); break; } } } } while (0)

struct XcdBarrier {
    unsigned* bar; unsigned x;
    volatile LAS unsigned* st;
};

__device__ __forceinline__ XcdBarrier xcd_barrier_post(unsigned* bar, volatile LAS unsigned* st) {
    XcdBarrier b; b.bar = bar; b.x = xb_xcc_id(); b.st = st;
    if (threadIdx.x == 0) (void)xb_add(&bar[XB_XCNT(b.x)], 1u);
    return b;
}
__device__ __forceinline__ void xcd_barrier_complete(unsigned* bar, unsigned x, unsigned& nloc, unsigned& nx) {
    const unsigned G = gridDim.x * gridDim.y * gridDim.z;
    unsigned sum, cnt, mine, sp = 0u;
    for (;;) {
        sum = 0u; cnt = 0u; mine = 0u;
#pragma unroll
        for (unsigned j = 0; j < 16; ++j) { const unsigned c = xb_ld(&bar[XB_XCNT(j)]); sum += c; cnt += (c > 0u) ? 1u : 0u; mine = (j == x) ? c : mine; }
        if (sum == G) break;
        __builtin_amdgcn_s_sleep(1);
        if ((++sp & 255u) == 0u) { if (xb_ld(&bar[XB_TMO])) break; if (sp > XB_SPIN_CAP) { atomicAdd(&bar[XB_TMO], 1u); break; } }
    }
    nloc = mine > 0u ? mine : 1u; nx = cnt > 0u ? cnt : 1u;
}

__device__ __forceinline__ void xcd_barrier(const XcdBarrier& b) {
    asm volatile("s_waitcnt vmcnt(0)" ::: "memory");
    __syncthreads();
    if (threadIdx.x == 0) {
        unsigned* bar = b.bar; asm volatile("" : "+s"(bar));
        __builtin_amdgcn_s_waitcnt(0);
        const unsigned bx = xb_xcc_id();
        unsigned nloc = b.st[0], nx = b.st[1];
        if (nloc == 0u) { xcd_barrier_complete(bar, bx, nloc, nx); b.st[0] = nloc; b.st[1] = nx; }
        const unsigned old = xb_add(&bar[XB_XSUB(bx)], 1u);
        const unsigned gen = old / nloc;
        if (old + 1u == (gen + 1u) * nloc) {
            __builtin_amdgcn_fence(__ATOMIC_RELEASE, "agent");
            asm volatile("s_waitcnt vmcnt(0)" ::: "memory");
            const unsigned og = xb_add(&bar[XB_TOP], 1u);
            const unsigned tg = og / nx;
            if (og + 1u == (tg + 1u) * nx) xb_add(&bar[XB_TOPGEN], 1u);
            else XB_SPIN(xb_ld(&bar[XB_TOPGEN]) == tg, bar);
            __builtin_amdgcn_fence(__ATOMIC_ACQUIRE, "agent");
            xb_add(&bar[XB_XGEN(bx)], 1u);
            asm volatile("s_waitcnt vmcnt(0)" ::: "memory");
        } else {
            XB_SPIN(xb_ld(&bar[XB_XGEN(bx)]) == gen, bar);
            __builtin_amdgcn_fence(__ATOMIC_ACQUIRE, "agent");
            asm volatile("s_waitcnt vmcnt(0)" ::: "memory");
        }
    }
    __syncthreads();
}

struct Args { const float* in[31]; float* out; unsigned char* ws; int layer, ph, pad0, pad1; };
struct Ctx {
    LAS unsigned char* lds;
    float* X;
    unsigned char* ws;
    const __attribute__((address_space(4))) unsigned char* ka;
    int G, bid, wave;
};
#define PHASE_BASES() GAS unsigned char* ws_g_ = (GAS unsigned char*)C.ws; const __attribute__((address_space(4))) unsigned char* ka_ = C.ka; asm volatile("" : "+s"(ws_g_), "+s"(ka_)); unsigned char* ws = (unsigned char*)ws_g_; \
    int lane_; asm volatile("v_mbcnt_lo_u32_b32 %0, -1, 0\n\tv_mbcnt_hi_u32_b32 %0, -1, %0" : "=v"(lane_)); int wave_ = C.wave; asm volatile("" : "+s"(wave_)); const int P_lane = lane_, P_wave = wave_, P_tid = P_wave * 64 + P_lane; (void)P_tid; (void)P_lane; (void)P_wave; \
    int P_bid = C.bid, P_G = C.G; asm volatile("" : "+s"(P_bid), "+s"(P_G)); (void)P_bid; (void)P_G
typedef const GAS float* cfptr_t;
#define INP(i) ((const float*)(((const __attribute__((address_space(4))) cfptr_t*)ka_)[i]))

__device__ __forceinline__ void ph_init(const Ctx& C) {
    PHASE_BASES();
    {
        const size_t gt = (size_t)P_bid * (NWAVES * 64) + P_tid, GT = (size_t)P_G * (NWAVES * 64);
        v4u* wl = (v4u*)(ws + WS_WLORA); const size_t n1 = (size_t)1536 * 384 * 2 / 16;
        for (size_t i = gt; i < n1; i += GT) { const int row = (int)(i / 48), pc = (int)(i % 48);
            const bool written = row < 512 ? (pc < 8) : row < 1024 ? (pc >= 8 && pc < 16) : (pc >= 16 && pc < 36);
            if (!written) wl[i] = (v4u){0u, 0u, 0u, 0u}; }
        v4u* wk = (v4u*)(ws + WS_WKV); const size_t n3 = (size_t)1024 * 256 * 2 / 16;
        for (size_t i = gt; i < n3; i += GT) if ((i & 31) >= 16) wk[i] = (v4u){0u, 0u, 0u, 0u};
        v4u* wp = (v4u*)(ws + WS_WIN + (size_t)NIN * DM * 2); const size_t n2 = (size_t)(NINP - NIN) * DM * 2 / 16;
        for (size_t i = gt; i < n2; i += GT) wp[i] = (v4u){0u, 0u, 0u, 0u};
    }
    const float* xin = INP(0); bf16* XB = (bf16*)(ws + WS_XB); float* rss = (float*)(ws + WS_RSS);
    const int gw = P_bid * NWAVES + P_wave, NGW = P_G * NWAVES;
    for (int row = gw; row < MTOK; row += 2 * NGW) {
        const int row1 = row + NGW;
        const f32x4* xr0 = (const f32x4*)(xin + (size_t)row * DM) + P_lane; const f32x4* xr1 = (const f32x4*)(xin + (size_t)row1 * DM) + P_lane;
        v2u* xb0 = (v2u*)(XB + (size_t)row * DM) + P_lane; v2u* xb1 = (v2u*)(XB + (size_t)row1 * DM) + P_lane;
        f32x4 v0[4], v1[4];
#pragma unroll
        for (int j = 0; j < 4; ++j) { v0[j] = xr0[64 * j]; v1[j] = xr1[64 * j]; }
        float s0 = 0.f, s1 = 0.f;
#pragma unroll
        for (int j = 0; j < 4; ++j) { v2u w; w.x = pk2(v0[j][0], v0[j][1]); w.y = pk2(v0[j][2], v0[j][3]); xb0[64 * j] = w; s0 += (v0[j][0] * v0[j][0] + v0[j][1] * v0[j][1]) + (v0[j][2] * v0[j][2] + v0[j][3] * v0[j][3]);
            v2u u; u.x = pk2(v1[j][0], v1[j][1]); u.y = pk2(v1[j][2], v1[j][3]); xb1[64 * j] = u; s1 += (v1[j][0] * v1[j][0] + v1[j][1] * v1[j][1]) + (v1[j][2] * v1[j][2] + v1[j][3] * v1[j][3]); }
        s0 = wave_sum(s0); s1 = wave_sum(s1);
        if (P_lane < 16) { rss[(size_t)row * 16 + P_lane] = (P_lane == 0) ? s0 : 0.f; rss[(size_t)row1 * 16 + P_lane] = (P_lane == 0) ? s1 : 0.f; }
    }
}

__device__ __forceinline__ void cvt_item(const float* W, int N, const float* gain, bf16* dst, int dstK, int koff, int guw, int rowoff, int item, int lane, LAS float* scr) {
    const int nblk = N / 32, kb = item / nblk, nb = item % nblk, k0 = 32 * kb, n0 = 32 * nb;
    float wv[16], gv[16];
#pragma unroll
    for (int i = 0; i < 16; ++i) { const int kk = 2 * i + (lane >> 5); wv[i] = W[(size_t)(k0 + kk) * N + n0 + (lane & 31)]; gv[i] = gain ? gain[k0 + kk] : 1.0f; }
#pragma unroll
    for (int i = 0; i < 16; ++i) { const int kk = 2 * i + (lane >> 5); scr[kk * 33 + (lane & 31)] = wv[i] * gv[i]; }
    LDS_WAIT(); asm volatile("" ::: "memory");
    const int rbase = (guw >= 0) ? ((n0 >> 7) * 256 + guw * 128 + (n0 & 127)) : (rowoff + n0);
    const int c = lane & 3;
#pragma unroll
    for (int j = 0; j < 2; ++j) { const int n = (lane >> 2) + 16 * j; const LAS float* s = scr + (8 * c) * 33 + n;
        v4u o; o.x = pk2(s[0 * 33], s[1 * 33]); o.y = pk2(s[2 * 33], s[3 * 33]); o.z = pk2(s[4 * 33], s[5 * 33]); o.w = pk2(s[6 * 33], s[7 * 33]);
        *(v4u*)(dst + (size_t)(rbase + n) * dstK + koff + k0 + 8 * c) = o; }
    LDS_WAIT(); asm volatile("" ::: "memory");
}
constexpr int I_FF = (DM / 32) * (DFF / 32);
constexpr int I_IN = (DM / 32) * (NIN / 32), I_OUT = (DM / 32) * (DM / 32), I_Q = (256 / 32) * (768 / 32), I_KV = (128 / 32) * (1024 / 32);
constexpr int I_W2 = (64 / 32) * (512 / 32), I_G2 = (160 / 32) * (512 / 32);
constexpr int CVT_NE = 3 * I_FF + I_IN + I_Q + I_KV + 2 * I_W2 + I_G2;
constexpr int CVT_NL = I_OUT + 3 * I_FF;
#define CVT_ITEM_BODY(late, l, r_in) do { \
        int r = (r_in); const float* W; int N; const float* gain = nullptr; bf16* dst; int dstK, koff = 0, guw = -1, rowoff = 0; \
        const size_t offGU = (size_t)(l) * DM * DFF, offIN = (size_t)(l) * DM * NIN; \
        if (!(late)) { \
            if (r < I_FF)                { W = INP(2) + offGU;  N = DFF; gain = INP(1) + (l) * DM;  dst = (bf16*)(ws + WS_WGU1); dstK = DM; guw = 0; } \
            else if ((r -= I_FF) < I_FF) { W = INP(3) + offGU;  N = DFF; gain = INP(1) + (l) * DM;  dst = (bf16*)(ws + WS_WGU1); dstK = DM; guw = 1; } \
            else if ((r -= I_FF) < I_FF) { W = INP(4) + offGU;  N = DM;  dst = (bf16*)(ws + WS_WDN1); dstK = DFF; } \
            else if ((r -= I_FF) < I_IN) { W = INP(6) + offIN;  N = NIN; gain = INP(5) + (l) * DM;  dst = (bf16*)(ws + WS_WIN); dstK = DM; } \
            else if ((r -= I_IN) < I_Q)  { W = INP(8) + (size_t)(l) * 256 * 768;   N = 768;  dst = (bf16*)(ws + WS_WQ);  dstK = 256; } \
            else if ((r -= I_Q) < I_KV)  { W = INP(10) + (size_t)(l) * 128 * 1024; N = 1024; dst = (bf16*)(ws + WS_WKV); dstK = 256; } \
            else if ((r -= I_KV) < I_W2) { W = INP(15) + (size_t)(l) * 64 * 512;   N = 512;  dst = (bf16*)(ws + WS_WLORA); dstK = 384; } \
            else if ((r -= I_W2) < I_W2) { W = INP(17) + (size_t)(l) * 64 * 512;   N = 512;  dst = (bf16*)(ws + WS_WLORA); dstK = 384; koff = 64;  rowoff = 512; } \
            else { r -= I_W2;              W = INP(18) + (size_t)(l) * 160 * 512;  N = 512;  dst = (bf16*)(ws + WS_WLORA); dstK = 384; koff = 128; rowoff = 1024; } \
        } else { \
            if (r < I_OUT / 2)                     { W = INP(26) + (size_t)(l) * DM * DM; N = DM; gain = INP(24) + (l) * 512; dst = (bf16*)(ws + WS_WOUT); dstK = DM; } \
            else if ((r -= I_OUT / 2) < I_OUT / 2) { W = INP(26) + (size_t)(l) * DM * DM + (size_t)512 * DM; N = DM; gain = INP(25) + (l) * 512; dst = (bf16*)(ws + WS_WOUT); dstK = DM; koff = 512; } \
            else if ((r -= I_OUT / 2) < I_FF)      { W = INP(28) + offGU; N = DFF; gain = INP(27) + (l) * DM; dst = (bf16*)(ws + WS_WGU2); dstK = DM; guw = 0; } \
            else if ((r -= I_FF) < I_FF)           { W = INP(29) + offGU; N = DFF; gain = INP(27) + (l) * DM; dst = (bf16*)(ws + WS_WGU2); dstK = DM; guw = 1; } \
            else { r -= I_FF;                        W = INP(30) + offGU; N = DM;  dst = (bf16*)(ws + WS_WDN2); dstK = DFF; } \
        } \
        cvt_item(W, N, gain, dst, dstK, koff, guw, rowoff, r, P_lane, scr); } while (0)
__device__ __forceinline__ void ph_cvt_early0(const Ctx& C) {
    PHASE_BASES();
    LAS float* scr = (LAS float*)(C.lds + P_wave * 8192);
    const int gw = P_bid * NWAVES + P_wave, NGW = P_G * NWAVES;
    for (int it = gw; it < CVT_NE; it += NGW) CVT_ITEM_BODY(false, 0, it);
}
constexpr int CVT_CH = 32;
__device__ __forceinline__ void cvt_chunk(const Ctx& C, bool late, int l, int chunk) {
    PHASE_BASES();
    LAS float* scr = (LAS float*)(C.lds + P_wave * 8192);
    const int ntot = late ? CVT_NL : CVT_NE;
#pragma unroll 1
    for (int i = 0; i < CVT_CH / 8; ++i) { const int it = chunk * CVT_CH + i * 8 + P_wave; if (it >= ntot) break;
        if (late) CVT_ITEM_BODY(true, l, it); else CVT_ITEM_BODY(false, l, it); }
}
constexpr int CVT_NCH_L = (CVT_NL + CVT_CH - 1) / CVT_CH, CVT_NCH_E = (CVT_NE + CVT_CH - 1) / CVT_CH;
constexpr int CVT_NCH_E01 = 3 * I_FF / CVT_CH;
__device__ __forceinline__ int cvt_take(const Ctx& C, int set, int l, int max_chunks, int soft_limit) {
    if (l >= NLAYER) return 0;
    PHASE_BASES();
    unsigned* ctr = (unsigned*)(ws + WS_CTL) + 2048 + 64 * (3 * l + set);
    volatile LAS unsigned* slot = (volatile LAS unsigned*)(C.lds + MISC_OFF) + 17;
    const int total = set == 1 ? CVT_NCH_L : set == 0 ? CVT_NCH_E01 : CVT_NCH_E - CVT_NCH_E01;
    int n = 0;
    for (; n < max_chunks; ++n) {
        __syncthreads();
        if (P_tid == 0) { unsigned v = __hip_atomic_load(ctr, __ATOMIC_RELAXED, __HIP_MEMORY_SCOPE_AGENT);
            v = ((int)v < soft_limit) ? __hip_atomic_fetch_add(ctr, 1u, __ATOMIC_RELAXED, __HIP_MEMORY_SCOPE_AGENT) : 0x7fffffffu; *slot = v; }
        __syncthreads();
        const int idx = __builtin_amdgcn_readfirstlane((int)*slot);
        if (idx >= total) break;
        cvt_chunk(C, set == 1, l, set == 2 ? idx + CVT_NCH_E01 : idx);
    }
    return n;
}
__device__ __forceinline__ void cvt_drain_early(const Ctx& C, int l) {
    if (l >= NLAYER) return;
    PHASE_BASES();
    unsigned* c0 = (unsigned*)(ws + WS_CTL) + 2048 + 64 * (3 * l);
    volatile LAS unsigned* slot = (volatile LAS unsigned*)(C.lds + MISC_OFF) + 17;
    __syncthreads();
    if (P_tid == 0) { const unsigned v0 = __hip_atomic_load(c0, __ATOMIC_RELAXED, __HIP_MEMORY_SCOPE_AGENT), v2 = __hip_atomic_load(c0 + 128, __ATOMIC_RELAXED, __HIP_MEMORY_SCOPE_AGENT);
        *slot = ((int)v0 < CVT_NCH_E01 ? 1u : 0u) | ((int)v2 < CVT_NCH_E - CVT_NCH_E01 ? 2u : 0u); }
    __syncthreads();
    const unsigned m = (unsigned)__builtin_amdgcn_readfirstlane((int)*slot);
    if (m & 1u) cvt_take(C, 0, l, 1 << 20, CVT_NCH_E);
    if (m & 2u) cvt_take(C, 2, l, 1 << 20, CVT_NCH_E);
}
__device__ __forceinline__ void cvt_drain_mix(const Ctx& C, int l) {
    PHASE_BASES();
    unsigned* cl = (unsigned*)(ws + WS_CTL) + 2048 + 64 * (3 * l + 1);
    unsigned* ce = (unsigned*)(ws + WS_CTL) + 2048 + 64 * (3 * (l + 1));
    volatile LAS unsigned* slot = (volatile LAS unsigned*)(C.lds + MISC_OFF) + 17;
    __syncthreads();
    if (P_tid == 0) { const unsigned v1 = __hip_atomic_load(cl, __ATOMIC_RELAXED, __HIP_MEMORY_SCOPE_AGENT), v0 = __hip_atomic_load(ce, __ATOMIC_RELAXED, __HIP_MEMORY_SCOPE_AGENT);
        *slot = ((int)v1 < CVT_NCH_L ? 1u : 0u) | ((int)v0 < CVT_NCH_E01 - 128 ? 2u : 0u); }
    __syncthreads();
    const unsigned m = (unsigned)__builtin_amdgcn_readfirstlane((int)*slot);
    if (m & 1u) cvt_take(C, 1, l, 1 << 20, CVT_NCH_L);
    if (m & 2u) cvt_take(C, 0, l + 1, 1 << 20, CVT_NCH_E01 - 128);
}
__device__ __forceinline__ void ps8(const bf16* pr, bool hasprev, const float* mu, int c0, float (&o)[8]) {
    const v4u a = *(const v4u*)(pr + RW_OFF + c0);
    v4u b = (v4u){0u, 0u, 0u, 0u}; if (hasprev) b = *(const v4u*)(pr - NINP + RW_OFF + c0);
    const f32x4 m0 = *(const f32x4*)(mu + c0), m1 = *(const f32x4*)(mu + c0 + 4);
#pragma unroll
    for (int i = 0; i < 4; ++i) { const float x0 = bflo(a[i]), x1 = bfhi(a[i]), y0 = bflo(b[i]), y1 = bfhi(b[i]);
        const float mm0 = (i < 2) ? m0[2 * i] : m1[2 * i - 4], mm1 = (i < 2) ? m0[2 * i + 1] : m1[2 * i - 3];
        o[2 * i] = x0 + mm0 * (y0 - x0); o[2 * i + 1] = x1 + mm1 * (y1 - x1); }
}
__device__ __forceinline__ v4u pack8(const float (&o)[8]) { v4u w; w.x = pk2(o[0], o[1]); w.y = pk2(o[2], o[3]); w.z = pk2(o[4], o[5]); w.w = pk2(o[6], o[7]); return w; }
__device__ __forceinline__ void ph_prep_a(const Ctx& C, int l) {
    PHASE_BASES(); const int lane = P_lane;
    const bf16* P = (const bf16*)(ws + WS_P);
    bf16* QLN = (bf16*)(ws + WS_QLN); bf16* KVLN = (bf16*)(ws + WS_KVLN); bf16* LA = (bf16*)(ws + WS_LA); bf16* KPE = (bf16*)(ws + WS_KPE);
    const float* gq = INP(7) + l * 256; const float* gkv = INP(9) + l * 128; const float* mu = INP(13) + l * 1824;
    const int gw = P_bid * NWAVES + P_wave, NGW = P_G * NWAVES;
    for (int row = gw; row < MTOK; row += NGW) {
        const bf16* pr = P + (size_t)row * NINP; const bool hasprev = (row & (SEQ - 1)) != 0;
        {
            const v2u raw = *(const v2u*)(pr + 4 * lane);
            const float v0 = bflo(raw.x), v1 = bfhi(raw.x), v2 = bflo(raw.y), v3 = bfhi(raw.y);
            const float ss = wave_sum((v0 * v0 + v1 * v1) + (v2 * v2 + v3 * v3));
            const float rs = rsqrtf(ss * (1.0f / 256.0f) + EPS);
            const f32x4 g = *(const f32x4*)(gq + 4 * lane);
            v2u w; w.x = pk2(v0 * rs * g[0], v1 * rs * g[1]); w.y = pk2(v2 * rs * g[2], v3 * rs * g[3]);
            *(v2u*)(QLN + (size_t)row * 256 + 4 * lane) = w;
        }
        {
            const unsigned raw = *(const unsigned*)(pr + 256 + 2 * lane);
            const float v0 = bflo(raw), v1 = bfhi(raw);
            const float ss = wave_sum(v0 * v0 + v1 * v1);
            const float rs = rsqrtf(ss * (1.0f / 128.0f) + EPS);
            *(unsigned*)(KVLN + (size_t)row * 256 + 2 * lane) = pk2(v0 * rs * gkv[2 * lane], v1 * rs * gkv[2 * lane + 1]);
            *(unsigned*)(KVLN + (size_t)row * 256 + 128 + 2 * lane) = 0u;
        }
        if (lane < 16) *(unsigned*)(KPE + (size_t)row * 32 + 2 * lane) = *(const unsigned*)(pr + 384 + 2 * lane);
        if (lane < 48) {
            float o[8];
            if (lane < 8) { ps8(pr, hasprev, mu, 512 + 8 * lane, o);
#pragma unroll
                for (int e = 0; e < 8; ++e) o[e] = tanhf(o[e]); }
            else if (lane < 16) { ps8(pr, hasprev, mu, 1600 + 8 * (lane - 8), o); }
            else if (lane < 36) { ps8(pr, hasprev, mu, 1664 + 8 * (lane - 16), o);
#pragma unroll
                for (int e = 0; e < 8; ++e) o[e] = 1.0f / (1.0f + __expf(-o[e])); }
            else {
#pragma unroll
                for (int e = 0; e < 8; ++e) o[e] = 0.f; }
            *(v4u*)(LA + (size_t)row * 384 + 8 * lane) = pack8(o);
        }
    }
}

__device__ __forceinline__ void unpk8(const v4u w, float (&o)[8]) {
#pragma unroll
    for (int i = 0; i < 4; ++i) { o[2 * i] = bflo(w[i]); o[2 * i + 1] = bfhi(w[i]); }
}
__device__ __forceinline__ float grp8_sum(float v) { return pg8::oct_sum(v); }
__device__ __forceinline__ void ph_prep_c(const Ctx& C, int l) {
    PHASE_BASES(); const int lane = P_lane;
    const bf16* QRAW = (const bf16*)(ws + WS_QRAW); const bf16* KVRAW = (const bf16*)(ws + WS_KVRAW); const bf16* KPE = (const bf16*)(ws + WS_KPE);
    bf16* Q = (bf16*)(ws + WS_Q); bf16* K = (bf16*)(ws + WS_K); bf16* V = (bf16*)(ws + WS_V);
    const float* rope = (const float*)(ws + WS_ROPE);
    const float* qn = INP(11) + l * 96; const float* kn = INP(12) + l * 96;
    const int h = lane >> 3, sub = lane & 7; const bool pe = sub < 4;
    const bf16* P = (const bf16*)(ws + WS_P); const bf16* AS = (const bf16*)(ws + WS_AS); float* KN = (float*)(ws + WS_KN); float* BS = (float*)(ws + WS_BS);
    const float* mu = INP(13) + l * 1824; const float* k_k = INP(19) + l * 512; const float* k_a = INP(20) + l * 512; const float* r_k = INP(21) + l * 512;
    float kkc[8], kac[8], rkc[8];
#pragma unroll
    for (int e = 0; e < 8; ++e) { kkc[e] = k_k[8 * lane + e]; kac[e] = k_a[8 * lane + e]; rkc[e] = r_k[8 * lane + e]; }
    float gq0[8], gk0[8], gq1[8], gk1[8];
#pragma unroll
    for (int e = 0; e < 8; ++e) { gq0[e] = qn[8 * sub + e]; gk0[e] = kn[8 * sub + e]; gq1[e] = pe ? qn[64 + 8 * sub + e] : 0.f; gk1[e] = pe ? kn[64 + 8 * sub + e] : 0.f; }
    const float QSCALE = 0.10206207261596575f * 1.4426950408889634f;
    const int gw = P_bid * NWAVES + P_wave, NGW = P_G * NWAVES;
    for (int row = gw; row < MTOK; row += NGW) {
        const int b = row >> 12, s = row & (SEQ - 1);
        const size_t ho = ((size_t)(b * NHEAD + h) * SEQ + s);
        float cs[8], sn[8];
        {   const float* rp = rope + s * 32 + 8 * (sub & 1); const f32x4 c0 = *(const f32x4*)rp, c1 = *(const f32x4*)(rp + 4), s0 = *(const f32x4*)(rp + 16), s1 = *(const f32x4*)(rp + 20);
#pragma unroll
            for (int e = 0; e < 4; ++e) { cs[e] = c0[e]; cs[4 + e] = c1[e]; sn[e] = s0[e]; sn[4 + e] = s1[e]; } }
        {
            float x0[8], x1[8];
            unpk8(*(const v4u*)(QRAW + (size_t)row * 768 + h * 96 + 8 * sub), x0);
            if (pe) unpk8(*(const v4u*)(QRAW + (size_t)row * 768 + h * 96 + 64 + 8 * sub), x1); else {
#pragma unroll
                for (int e = 0; e < 8; ++e) x1[e] = 0.f; }
            float ss = 0.f;
#pragma unroll
            for (int e = 0; e < 8; ++e) ss += x0[e] * x0[e] + x1[e] * x1[e];
            const float rs = rsqrtf(grp8_sum(ss) * (1.0f / 96.0f) + EPS) * QSCALE;
            float y0[8], y1[8];
#pragma unroll
            for (int e = 0; e < 8; ++e) { y0[e] = x0[e] * rs * gq0[e]; const float t = x1[e] * rs * gq1[e]; const float pt = pg8::swz_xor<2>(t);
                y1[e] = (sub < 2) ? (t * cs[e] - pt * sn[e]) : (t * cs[e] + pt * sn[e]); }
            *(v4u*)(Q + ho * 96 + 8 * sub) = pack8(y0); if (pe) *(v4u*)(Q + ho * 96 + 64 + 8 * sub) = pack8(y1);
        }
        {
            float x0[8], x1[8];
            unpk8(*(const v4u*)(KVRAW + (size_t)row * 1024 + h * 128 + 8 * sub), x0);
            if (pe) unpk8(*(const v4u*)(KPE + (size_t)row * 32 + 8 * sub), x1); else {
#pragma unroll
                for (int e = 0; e < 8; ++e) x1[e] = 0.f; }
            float ss = 0.f;
#pragma unroll
            for (int e = 0; e < 8; ++e) ss += x0[e] * x0[e] + x1[e] * x1[e];
            const float rs = rsqrtf(grp8_sum(ss) * (1.0f / 96.0f) + EPS);
            float y0[8], y1[8];
#pragma unroll
            for (int e = 0; e < 8; ++e) { y0[e] = x0[e] * rs * gk0[e]; const float t = x1[e] * rs * gk1[e]; const float pt = pg8::swz_xor<2>(t);
                y1[e] = (sub < 2) ? (t * cs[e] - pt * sn[e]) : (t * cs[e] + pt * sn[e]); }
            *(v4u*)(K + ho * 96 + 8 * sub) = pack8(y0); if (pe) *(v4u*)(K + ho * 96 + 64 + 8 * sub) = pack8(y1);
            *(v4u*)(V + ho * 64 + 8 * sub) = *(const v4u*)(KVRAW + (size_t)row * 1024 + h * 128 + 64 + 8 * sub);
        }
        {
            const bf16* pr = P + (size_t)row * NINP; const bool hasprev = s != 0;
            float r[8], k[8], a[8];
            ps8(pr, hasprev, mu, 8 * lane, r); ps8(pr, hasprev, mu, 576 + 8 * lane, k);
            unpk8(*(const v4u*)(AS + (size_t)row * 512 + 8 * lane), a);
            float n2 = 0.f, bs = 0.f;
#pragma unroll
            for (int e = 0; e < 8; ++e) { const float kk = k[e] * kkc[e]; n2 += kk * kk; bs += r[e] * (k[e] * (1.0f + (a[e] - 1.0f) * kac[e])) * rkc[e]; }
            n2 = grp8_sum(n2); bs = grp8_sum(bs);
            if (sub == 0) { KN[(size_t)row * 8 + h] = 1.0f / fmaxf(sqrtf(n2), 1e-12f); BS[(size_t)row * 8 + h] = bs; }
        }
    }
}

constexpr int KROW = 208;
constexpr int VROW = 136;
constexpr int KT_BYTES = 64 * KROW, VT_BYTES = 64 * VROW, ATT_BUF = KT_BYTES + VT_BYTES;
__device__ __forceinline__ void att_unit(const Ctx& C, int u) {
    PHASE_BASES(); const int lane = P_lane, wid = P_wave, tid = P_tid;
    const bf16* Q = (const bf16*)(ws + WS_Q); const bf16* K = (const bf16*)(ws + WS_K); const bf16* V = (const bf16*)(ws + WS_V);
    bf16* YN = (bf16*)(ws + WS_YN); float* SSA = (float*)(ws + WS_SSA);
    const int r32 = lane & 31, hi = lane >> 5;
    {
        const int bh = u & 31, qb = 15 - (u >> 5);
        const int q0 = qb * 256, NT = (q0 + 256) / 64, q0w = q0 + 32 * wid, mylast = q0w >> 6;
        const bf16* Kh = K + (size_t)bh * SEQ * 96; const bf16* Vh = V + (size_t)bh * SEQ * 64;
        bf16x8 qf[6];
#pragma unroll
        for (int ks = 0; ks < 6; ++ks) qf[ks] = *(const bf16x8*)(Q + ((size_t)bh * SEQ + q0w + r32) * 96 + ks * 16 + hi * 8);
        f32x16 o0, o1;
#pragma unroll
        for (int i = 0; i < 16; ++i) { o0[i] = 0.f; o1[i] = 0.f; }
        float mref = 0.f, lrun = 0.f; bool first = true; f32x16 negm;
#pragma unroll
        for (int i = 0; i < 16; ++i) negm[i] = 0.f;
        v4u ka0, ka1 = (v4u){0u, 0u, 0u, 0u}, va, kb0, kb1 = (v4u){0u, 0u, 0u, 0u}, vb_;
#define ATT_LOAD(K0, K1, V_, tt) do { const v4u* kt = (const v4u*)(Kh + (size_t)(tt) * 64 * 96); const v4u* vt = (const v4u*)(Vh + (size_t)(tt) * 64 * 64); K0 = kt[tid]; if (tid < 256) K1 = kt[512 + tid]; V_ = vt[tid]; } while (0)
#define ATT_STORE(K0, K1, V_, bufoff) do { \
            { const int c = tid, rr = c / 12, cc = c % 12; *(LAS v4u*)(C.lds + (bufoff) + rr * KROW + cc * 16) = K0; } \
            if (tid < 256) { const int c = 512 + tid, rr = c / 12, cc = c % 12; *(LAS v4u*)(C.lds + (bufoff) + rr * KROW + cc * 16) = K1; } \
            { const int kv = tid >> 3, d0 = (tid & 7) * 8; LAS unsigned short* vbp = (LAS unsigned short*)(C.lds + (bufoff) + KT_BYTES) + kv; \
              _Pragma("unroll") for (int e = 0; e < 4; ++e) { vbp[(d0 + 2 * e) * (VROW / 2)] = (unsigned short)(V_[e] & 0xffffu); vbp[(d0 + 2 * e + 1) * (VROW / 2)] = (unsigned short)(V_[e] >> 16); } } \
        } while (0)
#define ATT_COMPUTE(T_, BUF_) do { \
            if ((T_) <= mylast) { \
                const LAS unsigned char* kb = C.lds + (BUF_); const LAS unsigned char* vb = C.lds + (BUF_) + KT_BYTES; \
                bf16x8 kf0[6], kf1[6]; \
_Pragma("unroll") \
                for (int ks = 0; ks < 6; ++ks) { kf0[ks] = *(const LAS bf16x8*)(kb + r32 * KROW + (ks * 16 + hi * 8) * 2); kf1[ks] = *(const LAS bf16x8*)(kb + (32 + r32) * KROW + (ks * 16 + hi * 8) * 2); } \
                s16x4 vlo[2][2][2], vhi[2][2][2]; \
_Pragma("unroll") \
                for (int hh = 0; hh < 2; ++hh) \
_Pragma("unroll") \
                    for (int s = 0; s < 2; ++s) \
_Pragma("unroll") \
                        for (int db = 0; db < 2; ++db) { const LAS unsigned char* vp = vb + (32 * db + r32) * VROW + (32 * hh + 16 * s + 4 * hi) * 2; \
                            vlo[hh][s][db] = *(const LAS s16x4*)(vp); vhi[hh][s][db] = *(const LAS s16x4*)(vp + 16); } \
                f32x16 p0 = __builtin_amdgcn_mfma_f32_32x32x16_bf16(kf0[0], qf[0], negm, 0, 0, 0); \
                f32x16 p1 = __builtin_amdgcn_mfma_f32_32x32x16_bf16(kf1[0], qf[0], negm, 0, 0, 0); \
_Pragma("unroll") \
                for (int ks = 1; ks < 6; ++ks) { \
                    p0 = __builtin_amdgcn_mfma_f32_32x32x16_bf16(kf0[ks], qf[ks], p0, 0, 0, 0); \
                    p1 = __builtin_amdgcn_mfma_f32_32x32x16_bf16(kf1[ks], qf[ks], p1, 0, 0, 0); \
                } \
                float mt = p0[0]; \
_Pragma("unroll") \
                for (int i = 1; i < 16; ++i) mt = fmaxf(mt, p0[i]); \
_Pragma("unroll") \
                for (int i = 0; i < 16; ++i) mt = fmaxf(mt, p1[i]); \
                mt = pg8::max_x32(mt); \
                if (__builtin_amdgcn_ballot_w64(first || mt > 8.0f) != 0ull) { \
                    const float dl = first ? mt : fmaxf(mt, 0.f); \
                    const float alpha = first ? 0.f : __builtin_amdgcn_exp2f(-dl); \
                    mref += dl; lrun *= alpha; \
_Pragma("unroll") \
                    for (int i = 0; i < 16; ++i) { p0[i] -= dl; p1[i] -= dl; o0[i] *= alpha; o1[i] *= alpha; negm[i] = -mref; } \
                    first = false; \
                } \
                float ls = 0.f; \
_Pragma("unroll") \
                for (int i = 0; i < 16; ++i) { p0[i] = __builtin_amdgcn_exp2f(p0[i]); p1[i] = __builtin_amdgcn_exp2f(p1[i]); ls += p0[i] + p1[i]; } \
                lrun += ls; \
_Pragma("unroll") \
                for (int hh = 0; hh < 2; ++hh) \
_Pragma("unroll") \
                    for (int s = 0; s < 2; ++s) { \
                        v4u pw; \
_Pragma("unroll") \
                        for (int e = 0; e < 4; ++e) { const float x0 = hh ? p1[8 * s + 2 * e] : p0[8 * s + 2 * e], x1 = hh ? p1[8 * s + 2 * e + 1] : p0[8 * s + 2 * e + 1]; \
                            pw[e] = pk2(x0, x1); } \
                        const bf16x8 pf = __builtin_bit_cast(bf16x8, pw); \
_Pragma("unroll") \
                        for (int db = 0; db < 2; ++db) { \
                            const s16x4 lo = vlo[hh][s][db], hi4 = vhi[hh][s][db]; \
                            const bf16x8 vf = (bf16x8){lo[0], lo[1], lo[2], lo[3], hi4[0], hi4[1], hi4[2], hi4[3]}; \
                            if (db == 0) o0 = __builtin_amdgcn_mfma_f32_32x32x16_bf16(vf, pf, o0, 0, 0, 0); \
                            else         o1 = __builtin_amdgcn_mfma_f32_32x32x16_bf16(vf, pf, o1, 0, 0, 0); \
                        } \
                    } \
            } \
        } while (0)
        __syncthreads();
        ATT_LOAD(ka0, ka1, va, 0); ATT_LOAD(kb0, kb1, vb_, 1);
        ATT_STORE(ka0, ka1, va, 0);
        __syncthreads();
        for (int t = 0; t < NT; t += 2) {
            if (t + 2 < NT) ATT_LOAD(ka0, ka1, va, t + 2);
            ATT_COMPUTE(t, 0);
            ATT_STORE(kb0, kb1, vb_, ATT_BUF);
            __syncthreads();
            if (t + 3 < NT) ATT_LOAD(kb0, kb1, vb_, t + 3);
            ATT_COMPUTE(t + 1, ATT_BUF);
            if (t + 2 < NT) ATT_STORE(ka0, ka1, va, 0);
            __syncthreads();
        }
#undef ATT_COMPUTE
#undef ATT_LOAD
#undef ATT_STORE
        const float lt = pg8::sum_x32(lrun); const float inv = 1.0f / lt;
        const int b = bh >> 3, h = bh & 7; const size_t token = (size_t)b * SEQ + q0w + r32;
        bf16* yp = YN + token * 1024 + h * 64; float ssq = 0.f;
#pragma unroll
        for (int g = 0; g < 4; ++g) {
            const float a0 = o0[4 * g] * inv, a1 = o0[4 * g + 1] * inv, a2 = o0[4 * g + 2] * inv, a3 = o0[4 * g + 3] * inv;
            const float c0 = o1[4 * g] * inv, c1 = o1[4 * g + 1] * inv, c2 = o1[4 * g + 2] * inv, c3 = o1[4 * g + 3] * inv;
            ssq += ((a0 * a0 + a1 * a1) + (a2 * a2 + a3 * a3)) + ((c0 * c0 + c1 * c1) + (c2 * c2 + c3 * c3));
            v2u w0; w0.x = pk2(a0, a1); w0.y = pk2(a2, a3); *(v2u*)(yp + 8 * g + 4 * hi) = w0;
            v2u w1; w1.x = pk2(c0, c1); w1.y = pk2(c2, c3); *(v2u*)(yp + 32 + 8 * g + 4 * hi) = w1;
        }
        ssq = pg8::sum_x32(ssq);
        if (hi == 0) SSA[token * 8 + h] = ssq;
    }
}


constexpr int SA_PITCH = 144, SA_BUF = 64 * SA_PITCH;
constexpr int SA_TOT = 14 * SA_BUF;
static_assert(SA_TOT + 2048 <= RING_BYTES, "scan LDS");
constexpr int SA_B14 = RING_BYTES + 4096;
static_assert(SA_B14 + SA_BUF <= LDS_BYTES, "scan LDS (15th buffer)");
typedef float f32x4s __attribute__((ext_vector_type(4)));
__device__ __forceinline__ void sa_mm(const LAS unsigned char* lds, int aoff, int btoff, f32x4s (&acc)[2], int r0, int c0, int l15, int q) {
#pragma unroll
    for (int ks = 0; ks < 2; ++ks) {
        const bf16x8 a = *(const LAS bf16x8*)(lds + aoff + (r0 + l15) * SA_PITCH + (32 * ks + 8 * q) * 2);
#pragma unroll
        for (int n = 0; n < 2; ++n) {
            const bf16x8 b = *(const LAS bf16x8*)(lds + btoff + (c0 + 16 * n + l15) * SA_PITCH + (32 * ks + 8 * q) * 2);
            acc[n] = __builtin_amdgcn_mfma_f32_16x16x32_bf16(a, b, acc[n], 0, 0, 0);
        }
    }
}
__device__ __forceinline__ void sa_mm_a2(const LAS unsigned char* lds, int aoff, int bt1, int bt2, f32x4s (&acc1)[2], f32x4s (&acc2)[2], int r0, int c0, int l15, int q) {
#pragma unroll
    for (int ks = 0; ks < 2; ++ks) {
        const bf16x8 a = *(const LAS bf16x8*)(lds + aoff + (r0 + l15) * SA_PITCH + (32 * ks + 8 * q) * 2);
#pragma unroll
        for (int n = 0; n < 2; ++n) {
            const bf16x8 b1 = *(const LAS bf16x8*)(lds + bt1 + (c0 + 16 * n + l15) * SA_PITCH + (32 * ks + 8 * q) * 2);
            const bf16x8 b2 = *(const LAS bf16x8*)(lds + bt2 + (c0 + 16 * n + l15) * SA_PITCH + (32 * ks + 8 * q) * 2);
            acc1[n] = __builtin_amdgcn_mfma_f32_16x16x32_bf16(a, b1, acc1[n], 0, 0, 0);
            acc2[n] = __builtin_amdgcn_mfma_f32_16x16x32_bf16(a, b2, acc2[n], 0, 0, 0);
        }
    }
}
__device__ __forceinline__ void sa_mm_b2(const LAS unsigned char* lds, int a1off, int a2off, int btoff, f32x4s (&acc1)[2], f32x4s (&acc2)[2], int r0, int c0, int l15, int q) {
#pragma unroll
    for (int ks = 0; ks < 2; ++ks) {
        const bf16x8 a1 = *(const LAS bf16x8*)(lds + a1off + (r0 + l15) * SA_PITCH + (32 * ks + 8 * q) * 2);
        const bf16x8 a2 = *(const LAS bf16x8*)(lds + a2off + (r0 + l15) * SA_PITCH + (32 * ks + 8 * q) * 2);
#pragma unroll
        for (int n = 0; n < 2; ++n) {
            const bf16x8 b = *(const LAS bf16x8*)(lds + btoff + (c0 + 16 * n + l15) * SA_PITCH + (32 * ks + 8 * q) * 2);
            acc1[n] = __builtin_amdgcn_mfma_f32_16x16x32_bf16(a1, b, acc1[n], 0, 0, 0);
            acc2[n] = __builtin_amdgcn_mfma_f32_16x16x32_bf16(a2, b, acc2[n], 0, 0, 0);
        }
    }
}
__device__ __forceinline__ void sa_zero(f32x4s (&acc)[2]) { acc[0] = (f32x4s){0.f, 0.f, 0.f, 0.f}; acc[1] = (f32x4s){0.f, 0.f, 0.f, 0.f}; }
__device__ __forceinline__ void sa_mask(f32x4s (&acc)[2], int r0, int c0, int l15, int q, bool incl, bool tr = false) {
#pragma unroll
    for (int n = 0; n < 2; ++n)
#pragma unroll
        for (int i = 0; i < 4; ++i) { const int row = r0 + 4 * q + i, col = c0 + 16 * n + l15; const int lo = tr ? row : col, hi = tr ? col : row; const bool keep = incl ? (lo <= hi) : (lo < hi); if (!keep) acc[n][i] = 0.f; }
}
__device__ __forceinline__ void sa_storeT(LAS unsigned char* lds, int off, const f32x4s (&acc)[2], int r0, int c0, int l15, int q, bool plus_eye) {
#pragma unroll
    for (int n = 0; n < 2; ++n) { const int col = c0 + 16 * n + l15, row = r0 + 4 * q; f32x4s v = acc[n];
        if (plus_eye) {
#pragma unroll
            for (int i = 0; i < 4; ++i) if (row + i == col) v[i] += 1.0f; }
        v2u w; w.x = pk2(v[0], v[1]); w.y = pk2(v[2], v[3]);
        *(LAS v2u*)(lds + off + col * SA_PITCH + row * 2) = w; }
}
__device__ __forceinline__ void sa_storeN(LAS unsigned char* lds, int off, const f32x4s (&acc)[2], int r0, int c0, int l15, int q) {
#pragma unroll
    for (int n = 0; n < 2; ++n)
#pragma unroll
        for (int i = 0; i < 4; ++i) ((LAS unsigned short*)(lds + off + (r0 + 4 * q + i) * SA_PITCH))[c0 + 16 * n + l15] = (unsigned short)f2bf(acc[n][i]);
}
__device__ __forceinline__ void sa_loadT(const LAS unsigned char* lds, int off, f32x4s (&acc)[2], int r0, int c0, int l15, int q) {
#pragma unroll
    for (int n = 0; n < 2; ++n) { const v2u w = *(const LAS v2u*)(lds + off + (c0 + 16 * n + l15) * SA_PITCH + (r0 + 4 * q) * 2);
        acc[n] = (f32x4s){bflo(w.x), bfhi(w.x), bflo(w.y), bfhi(w.y)}; }
}
#define SBUF(n) ((n) * SA_BUF)
#define SA_BAR() asm volatile("s_waitcnt lgkmcnt(0)\n\ts_barrier" ::: "memory")
__device__ __forceinline__ void ph_scan_a(const Ctx& C, int l) {
    PHASE_BASES(); const int lane = P_lane, w = P_wave;
    const bf16* P = (const bf16*)(ws + WS_P); const bf16* AS = (const bf16*)(ws + WS_AS); const float* LW = (const float*)(ws + WS_DEC); const float* KN = (const float*)(ws + WS_KN);
    const float* mu = INP(13) + l * 1824; const float* k_k = INP(19) + l * 512; const float* k_a = INP(20) + l * 512;
    bf16* Pg = (bf16*)(ws + WS_SP); bf16* QTg = (bf16*)(ws + WS_SQT); bf16* RHg = (bf16*)(ws + WS_SRH); bf16* YVTg = (bf16*)(ws + WS_SYVT);
    LAS unsigned char* lds = C.lds;
    LAS float* tot = (LAS float*)(lds + SA_TOT);
    const int r0 = 16 * (w >> 1), c0 = 32 * (w & 1), l15 = lane & 15, q = lane >> 4;
    unsigned short xr[9], xk[9], xv[9], xa[8]; float lw[8], xn[8];
#define SA_LOAD(u_) do { const int bh_ = (u_) >> 6, c_ = (u_) & 63, b_ = bh_ >> 3, h_ = bh_ & 7; const size_t tok_ = (size_t)b_ * SEQ + 64 * c_ + 8 * w; \
        const bf16* pp = P + tok_ * NINP + RW_OFF + 64 * h_ + lane; const bool hasprev = (64 * c_ + 8 * w) != 0; const size_t e_ = tok_ * 512 + 64 * h_ + lane; \
        xr[0] = hasprev ? pp[-NINP] : (unsigned short)0; xk[0] = hasprev ? pp[-NINP + 576] : (unsigned short)0; xv[0] = hasprev ? pp[-NINP + 1088] : (unsigned short)0; \
        _Pragma("unroll") for (int j = 0; j < 8; ++j) { xr[j + 1] = pp[(size_t)j * NINP]; xk[j + 1] = pp[(size_t)j * NINP + 576]; xv[j + 1] = pp[(size_t)j * NINP + 1088]; \
            lw[j] = LW[e_ + (size_t)j * 512]; xa[j] = AS[e_ + (size_t)j * 512]; xn[j] = KN[(tok_ + j) * 8 + h_]; } } while (0)
    const int ubase = ((P_bid >> 6) * 8) * 64 + (P_bid & 63);
    SA_LOAD(ubase);
    for (int hh = 0; hh < 8; ++hh) { const int unit = ubase + 64 * hh;
        const int bh = unit >> 6, h = bh & 7;
        const int ch = 64 * h + lane;
        const float mu_r = mu[ch], mu_k = mu[576 + ch], mu_v = mu[1088 + ch], kkc = k_k[ch], kac = k_a[ch];
        float cum[8];
        cum[0] = lw[0];
#pragma unroll
        for (int j = 1; j < 8; ++j) cum[j] = cum[j - 1] + lw[j];
        tot[w * 64 + lane] = cum[7];
        float lwv[8], rr[8], k2[8], kkn[8], kka[8], vsh[8];
#pragma unroll
        for (int j = 0; j < 8; ++j) {
            const float p1 = bf2f(xr[j + 1]), p0 = bf2f(xr[j]), q1 = bf2f(xk[j + 1]), q0 = bf2f(xk[j]), v1 = bf2f(xv[j + 1]), v0 = bf2f(xv[j]);
            const float r = p1 + mu_r * (p0 - p1), k = q1 + mu_k * (q0 - q1);
            const float a = bf2f(xa[j]);
            const float kn = k * kkc * xn[j];
            lwv[j] = lw[j]; rr[j] = r; k2[j] = k * (1.0f + (a - 1.0f) * kac); kkn[j] = kn; kka[j] = kn * a; vsh[j] = v1 + mu_v * (v0 - v1);
        }
        if (hh + 1 < 8) SA_LOAD(unit + 64);
        SA_BAR();
        float offs = 0.f, total = 0.f;
#pragma unroll
        for (int ww = 0; ww < 8; ++ww) { const float t = tot[ww * 64 + lane]; total += t; if (ww < w) offs += t; }
        unsigned short at[8], bt[8], kt[8], rt[8], bhh[8], khh[8], vv[8];
#pragma unroll
        for (int j = 0; j < 8; ++j) {
            const float cj = offs + cum[j];
            const float eprev = __expf(cj - lwv[j]), eneg = __expf(-cj), epos = __expf(cj), ehat = __expf(total - cj);
            vv[j] = (unsigned short)f2bf(vsh[j]);
            at[j] = (unsigned short)f2bf(-kkn[j] * eprev); bt[j] = (unsigned short)f2bf(kka[j] * eneg); kt[j] = (unsigned short)f2bf(k2[j] * eneg); rt[j] = (unsigned short)f2bf(rr[j] * epos);
            bhh[j] = (unsigned short)f2bf(kka[j] * ehat); khh[j] = (unsigned short)f2bf(k2[j] * ehat);
        }
#pragma unroll
        for (int j = 0; j < 8; ++j) { const int i = 8 * w + j;
            ((LAS unsigned short*)(lds + SBUF(0) + i * SA_PITCH))[lane] = at[j]; ((LAS unsigned short*)(lds + SBUF(1) + i * SA_PITCH))[lane] = bt[j];
            ((LAS unsigned short*)(lds + SBUF(2) + i * SA_PITCH))[lane] = kt[j]; ((LAS unsigned short*)(lds + SBUF(3) + i * SA_PITCH))[lane] = rt[j]; }
#define PK8(x) ((v4u){(unsigned)x[0] | ((unsigned)x[1] << 16), (unsigned)x[2] | ((unsigned)x[3] << 16), (unsigned)x[4] | ((unsigned)x[5] << 16), (unsigned)x[6] | ((unsigned)x[7] << 16)})
        *(LAS v4u*)(lds + SBUF(4) + lane * SA_PITCH + 16 * w) = PK8(at);  *(LAS v4u*)(lds + SBUF(5) + lane * SA_PITCH + 16 * w) = PK8(bhh);
        *(LAS v4u*)(lds + SBUF(6) + lane * SA_PITCH + 16 * w) = PK8(khh); *(LAS v4u*)(lds + SBUF(7) + lane * SA_PITCH + 16 * w) = PK8(vv);
#undef PK8
        SA_BAR();
        f32x4s acc[2];
        sa_zero(acc); sa_mm(lds, SBUF(0), SBUF(1), acc, r0, c0, l15, q); sa_mask(acc, r0, c0, l15, q, false);
        sa_storeN(lds, SBUF(8), acc, r0, c0, l15, q); sa_storeT(lds, SBUF(9), acc, r0, c0, l15, q, false); sa_storeT(lds, SBUF(10), acc, r0, c0, l15, q, true);
        f32x4s acc2[2];
        sa_zero(acc); sa_zero(acc2); sa_mm_a2(lds, SBUF(2), SBUF(0), SBUF(3), acc, acc2, r0, c0, l15, q);
        sa_mask(acc, r0, c0, l15, q, false, true); sa_mask(acc2, r0, c0, l15, q, true, true);
        sa_storeT(lds, SBUF(11), acc, r0, c0, l15, q, false); sa_storeT(lds, SBUF(12), acc2, r0, c0, l15, q, false);
        sa_zero(acc); sa_mm(lds, SBUF(1), SBUF(3), acc, r0, c0, l15, q); sa_mask(acc, r0, c0, l15, q, true, true);
        sa_storeT(lds, SA_B14, acc, r0, c0, l15, q, false);
        SA_BAR();
        sa_zero(acc); sa_mm(lds, SBUF(8), SBUF(9), acc, r0, c0, l15, q); sa_storeN(lds, SBUF(1), acc, r0, c0, l15, q); sa_storeT(lds, SBUF(2), acc, r0, c0, l15, q, false);
        SA_BAR();
        sa_loadT(lds, SBUF(10), acc, r0, c0, l15, q); sa_zero(acc2); sa_mm_a2(lds, SBUF(1), SBUF(10), SBUF(2), acc, acc2, r0, c0, l15, q);
        sa_storeT(lds, SBUF(13), acc, r0, c0, l15, q, false); sa_storeN(lds, SBUF(8), acc2, r0, c0, l15, q); sa_storeT(lds, SBUF(9), acc2, r0, c0, l15, q, false);
        SA_BAR();
        sa_loadT(lds, SBUF(13), acc, r0, c0, l15, q); sa_zero(acc2); sa_mm_a2(lds, SBUF(8), SBUF(13), SBUF(9), acc, acc2, r0, c0, l15, q);
        sa_storeT(lds, SBUF(10), acc, r0, c0, l15, q, false); sa_storeN(lds, SBUF(1), acc2, r0, c0, l15, q); sa_storeT(lds, SBUF(2), acc2, r0, c0, l15, q, false);
        SA_BAR();
        sa_loadT(lds, SBUF(10), acc, r0, c0, l15, q); sa_zero(acc2); sa_mm_a2(lds, SBUF(1), SBUF(10), SBUF(2), acc, acc2, r0, c0, l15, q);
        sa_storeT(lds, SBUF(13), acc, r0, c0, l15, q, false); sa_storeN(lds, SBUF(8), acc2, r0, c0, l15, q); sa_storeT(lds, SBUF(9), acc2, r0, c0, l15, q, false);
        SA_BAR();
        sa_loadT(lds, SBUF(13), acc, r0, c0, l15, q); sa_zero(acc2); sa_mm_a2(lds, SBUF(8), SBUF(13), SBUF(9), acc, acc2, r0, c0, l15, q);
        sa_storeT(lds, SBUF(10), acc, r0, c0, l15, q, false); sa_storeN(lds, SBUF(1), acc2, r0, c0, l15, q);
        SA_BAR();
        sa_loadT(lds, SBUF(10), acc, r0, c0, l15, q); sa_mm(lds, SBUF(1), SBUF(10), acc, r0, c0, l15, q); sa_storeN(lds, SBUF(13), acc, r0, c0, l15, q);
        sa_zero(acc); sa_mm(lds, SBUF(11), SBUF(7), acc, r0, c0, l15, q); sa_storeT(lds, SBUF(2), acc, r0, c0, l15, q, false);
        SA_BAR();
        sa_zero(acc); sa_zero(acc2); sa_mm_a2(lds, SBUF(13), SBUF(4), SBUF(2), acc, acc2, r0, c0, l15, q);
        sa_storeT(lds, SBUF(8), acc, r0, c0, l15, q, false); sa_storeT(lds, SBUF(9), acc2, r0, c0, l15, q, false);
        SA_BAR();
        const size_t ub = (size_t)unit * 4096;
        f32x4s accR[2], accQ[2];
        sa_zero(acc); sa_zero(accR); sa_mm_a2(lds, SBUF(8), SBUF(5), SA_B14, acc, accR, r0, c0, l15, q);
        sa_zero(accQ); sa_zero(acc2);
        sa_mm_b2(lds, SBUF(6), SBUF(12), SBUF(7), accQ, acc2, r0, c0, l15, q);
        sa_mm_b2(lds, SBUF(5), SA_B14, SBUF(9), accQ, acc2, r0, c0, l15, q);
        {
#pragma unroll
            for (int n = 0; n < 2; ++n) { const int k = c0 + 16 * n + l15; float tc = 0.f;
#pragma unroll
                for (int ww = 0; ww < 8; ++ww) tc += tot[ww * 64 + k];
                const float gam = __expf(tc);
                const int j0 = r0 + 4 * q, o = j0 & 15, jp = (j0 & ~15) | ((o & 4) << 1) | ((o & 8) >> 1);
                float v[4];
#pragma unroll
                for (int i = 0; i < 4; ++i) v[i] = acc[n][i] + ((j0 + i) == k ? gam : 0.f);
                v2u wv; wv.x = pk2(v[0], v[1]); wv.y = pk2(v[2], v[3]);
                *(LAS v2u*)(lds + SBUF(1) + k * SA_PITCH + jp * 2) = wv; }
        }
        {
#pragma unroll
            for (int n = 0; n < 2; ++n) { v2u wv; wv.x = pk2(accQ[n][0], accQ[n][1]); wv.y = pk2(accQ[n][2], accQ[n][3]); const int k0 = r0 + 4 * q;
                *(LAS v2u*)(lds + SBUF(4) + (c0 + 16 * n + l15) * SA_PITCH + ((k0 & 32) + 16 * ((k0 >> 2) & 1) + 4 * ((k0 & 31) >> 3)) * 2) = wv; }
        }
        {
#pragma unroll
            for (int n = 0; n < 2; ++n) { const int tk = c0 + 16 * n + l15, k0 = r0 + 4 * q;
                const v2u rv = *(const LAS v2u*)(lds + SBUF(3) + tk * SA_PITCH + k0 * 2);
                v2u wv; wv.x = pk2(accR[n][0] + bflo(rv.x), accR[n][1] + bfhi(rv.x)); wv.y = pk2(accR[n][2] + bflo(rv.y), accR[n][3] + bfhi(rv.y));
                *(LAS v2u*)(lds + SBUF(2) + tk * SA_PITCH + k0 * 2) = wv; }
        }
        sa_storeT(lds, SBUF(10), acc2, r0, c0, l15, q, false);
        SA_BAR();
        {   const int tid_ = w * 64 + lane, row = tid_ >> 3, cc = tid_ & 7;
            *(v4u*)(Pg + ub + row * 64 + 8 * cc) = *(const LAS v4u*)(lds + SBUF(1) + row * SA_PITCH + 16 * cc);
            *(v4u*)(RHg + ub + row * 64 + 8 * cc) = *(const LAS v4u*)(lds + SBUF(2) + row * SA_PITCH + 16 * cc);
            *(v4u*)(QTg + ub + row * 64 + 8 * cc) = *(const LAS v4u*)(lds + SBUF(4) + row * SA_PITCH + 16 * cc);
            *(v4u*)(YVTg + ub + row * 64 + 8 * cc) = *(const LAS v4u*)(lds + SBUF(10) + row * SA_PITCH + 16 * cc); }
    }
}
__device__ __forceinline__ void ph_scan_b(const Ctx& C) {
    PHASE_BASES(); const int lane = P_lane;
    const bf16* Pg = (const bf16*)(ws + WS_SP); const bf16* QTg = (const bf16*)(ws + WS_SQT); bf16* HS = (bf16*)(ws + WS_SHS);
    const int r32 = lane & 31, hi = lane >> 5;
    if (P_wave != 0) return;
    for (int task = P_bid; task < 64; task += P_G) {
        const int bh = task >> 1, vb = task & 1, vcol = 32 * vb + r32;
        f32x16 h0, h1;
#pragma unroll
        for (int i = 0; i < 16; ++i) { h0[i] = 0.f; h1[i] = 0.f; }
        v4u paA[2][2][2], qqA[2][2], paB[2][2][2], qqB[2][2], paC[2][2][2], qqC[2][2];
#define SB_LOAD(PA, QQ, cc) do { const size_t ub_ = ((size_t)bh * 64 + (cc)) * 4096; \
            _Pragma("unroll") for (int t1 = 0; t1 < 2; ++t1) { \
                _Pragma("unroll") for (int t0 = 0; t0 < 2; ++t0) _Pragma("unroll") for (int s = 0; s < 2; ++s) PA[t1][t0][s] = *(const v4u*)(Pg + ub_ + (32 * t1 + r32) * 64 + 32 * t0 + 16 * s + 8 * hi); \
                QQ[t1][0] = *(const v4u*)(QTg + ub_ + vcol * 64 + 32 * t1 + 16 * hi); QQ[t1][1] = *(const v4u*)(QTg + ub_ + vcol * 64 + 32 * t1 + 16 * hi + 8); } } while (0)
#define SB_STEP(cc, PA, QQ, PN, QN) do { \
            bf16* hs = HS + ((size_t)bh * 64 + (cc)) * 4096 + vcol * 64; \
            v4u hb[2][2]; \
            _Pragma("unroll") for (int s = 0; s < 2; ++s) _Pragma("unroll") for (int e = 0; e < 4; ++e) { hb[0][s][e] = pk2(h0[8 * s + 2 * e], h0[8 * s + 2 * e + 1]); hb[1][s][e] = pk2(h1[8 * s + 2 * e], h1[8 * s + 2 * e + 1]); } \
            _Pragma("unroll") for (int g = 0; g < 4; ++g) { \
                v2u w0; w0.x = hb[0][g >> 1][2 * (g & 1)]; w0.y = hb[0][g >> 1][2 * (g & 1) + 1]; *(v2u*)(hs + 8 * g + 4 * hi) = w0; \
                v2u w1; w1.x = hb[1][g >> 1][2 * (g & 1)]; w1.y = hb[1][g >> 1][2 * (g & 1) + 1]; *(v2u*)(hs + 32 + 8 * g + 4 * hi) = w1; } \
            if ((cc) + 2 < 64) SB_LOAD(PN, QN, (cc) + 2); \
            f32x16 n0, n1; \
            _Pragma("unroll") for (int g = 0; g < 4; ++g) { const unsigned a0 = QQ[0][g >> 1][2 * (g & 1)], a1 = QQ[0][g >> 1][2 * (g & 1) + 1], b0 = QQ[1][g >> 1][2 * (g & 1)], b1 = QQ[1][g >> 1][2 * (g & 1) + 1]; \
                n0[4 * g] = bflo(a0); n0[4 * g + 1] = bfhi(a0); n0[4 * g + 2] = bflo(a1); n0[4 * g + 3] = bfhi(a1); \
                n1[4 * g] = bflo(b0); n1[4 * g + 1] = bfhi(b0); n1[4 * g + 2] = bflo(b1); n1[4 * g + 3] = bfhi(b1); } \
            _Pragma("unroll") for (int t0 = 0; t0 < 2; ++t0) _Pragma("unroll") for (int s = 0; s < 2; ++s) { const bf16x8 bfr = __builtin_bit_cast(bf16x8, hb[t0][s]); \
                n0 = __builtin_amdgcn_mfma_f32_32x32x16_bf16(__builtin_bit_cast(bf16x8, PA[0][t0][s]), bfr, n0, 0, 0, 0); \
                n1 = __builtin_amdgcn_mfma_f32_32x32x16_bf16(__builtin_bit_cast(bf16x8, PA[1][t0][s]), bfr, n1, 0, 0, 0); } \
            h0 = n0; h1 = n1; } while (0)
        SB_LOAD(paA, qqA, 0); SB_LOAD(paB, qqB, 1);
#pragma nounroll
        for (int c = 0; c < 63; c += 3) {
            SB_STEP(c, paA, qqA, paC, qqC);
            SB_STEP(c + 1, paB, qqB, paA, qqA);
            SB_STEP(c + 2, paC, qqC, paB, qqB);
        }
        {   bf16* hs = HS + ((size_t)bh * 64 + 63) * 4096 + vcol * 64;
#pragma unroll
            for (int g = 0; g < 4; ++g) {
                v2u w0; w0.x = pk2(h0[4 * g], h0[4 * g + 1]); w0.y = pk2(h0[4 * g + 2], h0[4 * g + 3]); *(v2u*)(hs + 8 * g + 4 * hi) = w0;
                v2u w1; w1.x = pk2(h1[4 * g], h1[4 * g + 1]); w1.y = pk2(h1[4 * g + 2], h1[4 * g + 3]); *(v2u*)(hs + 32 + 8 * g + 4 * hi) = w1; } }
#undef SB_STEP
#undef SB_LOAD
    }
}
__device__ __forceinline__ float grp16_sum(float v) { return pg8::row16_sum(v); }
__device__ __forceinline__ void ph_scan_c(const Ctx& C, int l) {
    PHASE_BASES(); const int lane = P_lane, w = P_wave;
    const bf16* RHg = (const bf16*)(ws + WS_SRH); const bf16* YVTg = (const bf16*)(ws + WS_SYVT); const bf16* HS = (const bf16*)(ws + WS_SHS);
    const bf16* P = (const bf16*)(ws + WS_P); const bf16* G = (const bf16*)(ws + WS_G); const float* BS = (const float*)(ws + WS_BS);
    bf16* YN = (bf16*)(ws + WS_YN); float* SSR = (float*)(ws + WS_SSR);
    const float* mu = INP(13) + l * 1824; const float* gng = INP(22) + l * 512; const float* gnb = INP(23) + l * 512;
    const int slot = w >> 2, r0 = 16 * (w & 3), l15 = lane & 15, q = lane >> 4;
    v2u yv[4]; bf16x8 af[2], bfr[2][4]; v4u pvx[3], gx[2];
#define SC_LOAD(up_) do { const int unit_ = 2 * (up_) + slot, bh_ = unit_ >> 6, c_ = unit_ & 63, b_ = bh_ >> 3, h_ = bh_ & 7; const size_t ub_ = (size_t)unit_ * 4096; const size_t tk_ = (size_t)b_ * SEQ + 64 * c_ + r0; \
        _Pragma("unroll") for (int n = 0; n < 4; ++n) yv[n] = *(const v2u*)(YVTg + ub_ + (16 * n + l15) * 64 + r0 + 4 * q); \
        _Pragma("unroll") for (int ks = 0; ks < 2; ++ks) { af[ks] = *(const bf16x8*)(RHg + ub_ + (r0 + l15) * 64 + 32 * ks + 8 * q); \
            _Pragma("unroll") for (int n = 0; n < 4; ++n) bfr[ks][n] = *(const bf16x8*)(HS + ub_ + (16 * n + l15) * 64 + 32 * ks + 8 * q); } \
        _Pragma("unroll") for (int k = 0; k < 3; ++k) { const int idx = lane + 64 * k; pvx[k] = (v4u){0u, 0u, 0u, 0u}; if (idx < 136) { const int r = idx >> 3, cc = idx & 7; \
            if (r > 0 || (64 * c_ + r0) != 0) pvx[k] = *(const v4u*)(P + (tk_ + r - 1) * NINP + RW_OFF + 1088 + 64 * h_ + 8 * cc); } } \
        _Pragma("unroll") for (int k = 0; k < 2; ++k) { const int idx = lane + 64 * k, r = idx >> 3, cc = idx & 7; gx[k] = *(const v4u*)(G + (tk_ + r) * 512 + 64 * h_ + 8 * cc); } } while (0)
    if (P_bid < 1024) SC_LOAD(P_bid);
    for (int up = P_bid; up < 1024; up += P_G) {
        const int unit = 2 * up + slot, bh = unit >> 6, c = unit & 63, b = bh >> 3, h = bh & 7;
        f32x4s acc[4];
#pragma unroll
        for (int n = 0; n < 4; ++n) acc[n] = (f32x4s){bflo(yv[n].x), bfhi(yv[n].x), bflo(yv[n].y), bfhi(yv[n].y)};
#pragma unroll
        for (int ks = 0; ks < 2; ++ks)
#pragma unroll
            for (int n = 0; n < 4; ++n) acc[n] = __builtin_amdgcn_mfma_f32_16x16x32_bf16(af[ks], bfr[ks][n], acc[n], 0, 0, 0);
        LAS unsigned char* wl = C.lds + w * 8192;
#pragma unroll
        for (int k = 0; k < 3; ++k) { const int idx = lane + 64 * k; if (idx < 136) { const int r = idx >> 3, cc = idx & 7; *(LAS v4u*)(wl + r * 144 + 16 * cc) = pvx[k]; } }
#pragma unroll
        for (int k = 0; k < 2; ++k) { const int idx = lane + 64 * k, r = idx >> 3, cc = idx & 7; *(LAS v4u*)(wl + 2560 + r * 144 + 16 * cc) = gx[k]; }
        float gg[4], gb[4], muv[4], bsv[4];
#pragma unroll
        for (int n = 0; n < 4; ++n) { const int ch = 64 * h + 16 * n + l15; gg[n] = gng[ch]; gb[n] = gnb[ch]; muv[n] = mu[1088 + ch]; }
        const size_t tok0 = (size_t)b * SEQ + 64 * c + r0;
#pragma unroll
        for (int i = 0; i < 4; ++i) bsv[i] = BS[(tok0 + 4 * q + i) * 8 + h];
        asm volatile("" ::: "memory");
        if (up + P_G < 1024) SC_LOAD(up + P_G);
#pragma unroll
        for (int i = 0; i < 4; ++i) {
            const int rr = 4 * q + i; const size_t token = tok0 + rr;
            const float mean = grp16_sum((acc[0][i] + acc[1][i]) + (acc[2][i] + acc[3][i])) * (1.0f / 64.0f);
            float d[4]; float v2s = 0.f;
#pragma unroll
            for (int n = 0; n < 4; ++n) { d[n] = acc[n][i] - mean; v2s += d[n] * d[n]; }
            const float rstd = rsqrtf(grp16_sum(v2s) * (1.0f / 64.0f) + 64e-5f);
            const float bs = bsv[i];
            float sq = 0.f;
#pragma unroll
            for (int n = 0; n < 4; ++n) { const int ch = 16 * n + l15;
                const float pvc = bf2f(((const LAS unsigned short*)(wl + (rr + 1) * 144))[ch]), pvp = bf2f(((const LAS unsigned short*)(wl + rr * 144))[ch]);
                const float v = pvc + muv[n] * (pvp - pvc);
                const float gt = bf2f(((const LAS unsigned short*)(wl + 2560 + rr * 144))[ch]);
                const float o = (d[n] * rstd * gg[n] + gb[n] + bs * v) * gt;
                ((LAS unsigned short*)(wl + 5120 + rr * 144))[ch] = (unsigned short)f2bf(o); sq += o * o;
            }
            sq = grp16_sum(sq);
            if (l15 == 0) SSR[token * 8 + h] = sq;
        }
#pragma unroll
        for (int k = 0; k < 2; ++k) { const int idx = lane + 64 * k, r = idx >> 3, cc = idx & 7;
            *(v4u*)(YN + (tok0 + r) * 1024 + 512 + 64 * h + 8 * cc) = *(const LAS v4u*)(wl + 5120 + r * 144 + 16 * cc); }
    }
}

__device__ __forceinline__ void ph_mix(const Ctx& C, int l) {
    ph_scan_b(C);
    PHASE_BASES();
    unsigned* qbase = (unsigned*)(ws + WS_CTL) + 3072 + 128 * l;
    volatile LAS unsigned* slot = (volatile LAS unsigned*)(C.lds + MISC_OFF) + 16;
    const int xcc = (int)(xb_xcc_id() & 7u);
    bool own = true;
    for (;;) {
        __syncthreads();
        if (P_tid == 0) {
            unsigned res = 0xffffffffu;
            if (own) { const unsigned v = __hip_atomic_fetch_add(qbase + 16 * xcc, 1u, __ATOMIC_RELAXED, __HIP_MEMORY_SCOPE_AGENT); if (v < 64u) res = ((unsigned)xcc << 8) | v; }
            if (res == 0xffffffffu) {
                unsigned c[8];
#pragma unroll
                for (int k = 1; k < 8; ++k) c[k] = __hip_atomic_load(qbase + 16 * ((xcc + k) & 7), __ATOMIC_RELAXED, __HIP_MEMORY_SCOPE_AGENT);
#pragma unroll
                for (int k = 1; k < 8; ++k) if (res == 0xffffffffu && c[k] < 64u) { const int qk = (xcc + k) & 7;
                    const unsigned v = __hip_atomic_fetch_add(qbase + 16 * qk, 1u, __ATOMIC_RELAXED, __HIP_MEMORY_SCOPE_AGENT); if (v < 64u) res = ((unsigned)qk << 8) | v; }
            }
            *slot = res;
        }
        __syncthreads();
        const unsigned r = (unsigned)__builtin_amdgcn_readfirstlane((int)*slot);
        if (r == 0xffffffffu) break;
        const int qk = (int)(r >> 8), j = (int)(r & 255u);
        if (qk != xcc) own = false;
        att_unit(C, (j >> 2) * 32 + 4 * qk + (j & 3));
    }
    cvt_drain_mix(C, l);
}

constexpr int PF_QP = 528, PF_KVP = 272, PF_LAP = 592;
constexpr int PF_AQ = 0, PF_AKV = PF_AQ + 64 * PF_QP, PF_ALA = PF_AKV + 64 * PF_KVP, PF_KPE = PF_ALA + 64 * PF_LAP, PF_STG = PF_KPE + 64 * 64;
constexpr int PF_SP = 272, PF_STGW = 16 * PF_SP, PF_END = PF_STG + 8 * PF_STGW;
static_assert(PF_END <= RING_BYTES, "PREP_F LDS");
typedef float f32x4p __attribute__((ext_vector_type(4)));
template <int NT, int KS> __device__ __forceinline__ void pf_mm(f32x4p (&acc)[4][NT], const LAS unsigned char* lds, int aoff, int apitch, int acol0, const bf16* Bt, int brow0, int ldb, int bcol0, int l15, int q) {
    bf16x8 bb[3][NT];
    const bf16* bp = Bt + (size_t)(brow0 + l15) * ldb + bcol0 + 8 * q;
#define PF_LDB(ks_) do { _Pragma("unroll") for (int n = 0; n < NT; ++n) bb[(ks_) % 3][n] = *(const bf16x8*)(bp + (size_t)(16 * n) * ldb + 32 * (ks_)); } while (0)
    PF_LDB(0); if (KS > 1) PF_LDB(1);
#pragma unroll
    for (int ks = 0; ks < KS; ++ks) {
        if (ks + 2 < KS) PF_LDB(ks + 2);
#pragma unroll
        for (int m = 0; m < 4; ++m) {
            const bf16x8 a = *(const LAS bf16x8*)(lds + aoff + (16 * m + l15) * apitch + (acol0 + 32 * ks) * 2 + 16 * q);
#pragma unroll
            for (int n = 0; n < NT; ++n) acc[m][n] = __builtin_amdgcn_mfma_f32_16x16x32_bf16(a, bb[ks % 3][n], acc[m][n], 0, 0, 0);
        }
        asm volatile("" ::: "memory");
    }
#undef PF_LDB
}
template <int NT> __device__ __forceinline__ void pf_out_bf16(const float (&v)[NT][4], LAS unsigned char* stg, bf16* g0, int gstride, int lane, int l15, int q) {
#pragma unroll
    for (int n = 0; n < NT; ++n)
#pragma unroll
        for (int i = 0; i < 4; ++i) ((LAS unsigned short*)(stg + (4 * q + i) * PF_SP))[16 * n + l15] = (unsigned short)f2bf(v[n][i]);
    constexpr int CH = 2 * NT;
#pragma unroll
    for (int k = 0; k < (16 * CH) / 64; ++k) { const int idx = lane + 64 * k, r = idx / CH, c = idx - r * CH;
        *(v4u*)(g0 + (size_t)r * gstride + 8 * c) = *(const LAS v4u*)(stg + r * PF_SP + 16 * c); }
}
__device__ __forceinline__ void pf_out_f32x64(const float (&v)[4][4], LAS unsigned char* stg, float* g0, int gstride, int lane, int l15, int q) {
#pragma unroll
    for (int hf = 0; hf < 2; ++hf) {
#pragma unroll
        for (int n = 0; n < 2; ++n)
#pragma unroll
            for (int i = 0; i < 4; ++i) ((LAS float*)(stg + (4 * q + i) * PF_SP))[16 * n + l15] = v[2 * hf + n][i];
#pragma unroll
        for (int k = 0; k < 2; ++k) { const int idx = lane + 64 * k, r = idx >> 3, c = idx & 7;
            *(f32x4*)(g0 + (size_t)r * gstride + 32 * hf + 4 * c) = *(const LAS f32x4*)(stg + r * PF_SP + 16 * c); }
    }
}
#ifndef PF_PARTS
#define PF_PARTS 7
#endif
__device__ __forceinline__ void ph_prep_f(const Ctx& C, int l) {
    PHASE_BASES(); const int lane = P_lane, w = P_wave;
    const bf16* P = (const bf16*)(ws + WS_P);
    LAS unsigned char* lds = C.lds;
    const int l15_ = lane & 15, q_ = lane >> 4;
    if (P_bid < MTOK / 64) {
        const int u = P_bid; const int t0 = 64 * u, b = t0 >> 12, s0 = t0 & (SEQ - 1);
        __syncthreads();
        {
            const float* gq = INP(7) + l * 256; const float* gkv = INP(9) + l * 128; const float* mu = INP(13) + l * 1824;
#pragma unroll 4
            for (int j = 0; j < 8; ++j) {
                const int tl = 8 * w + j, row = t0 + tl; const bf16* pr = P + (size_t)row * NINP; const bool hasprev = (s0 + tl) != 0;
                {   const v2u raw = *(const v2u*)(pr + 4 * lane);
                    const float v0 = bflo(raw.x), v1 = bfhi(raw.x), v2 = bflo(raw.y), v3 = bfhi(raw.y);
                    const float rs = rsqrtf(wave_sum((v0 * v0 + v1 * v1) + (v2 * v2 + v3 * v3)) * (1.0f / 256.0f) + EPS);
                    const f32x4 g = *(const f32x4*)(gq + 4 * lane);
                    v2u wq; wq.x = pk2(v0 * rs * g[0], v1 * rs * g[1]); wq.y = pk2(v2 * rs * g[2], v3 * rs * g[3]);
                    *(LAS v2u*)(lds + PF_AQ + tl * PF_QP + 8 * lane) = wq; }
                {   const unsigned raw = *(const unsigned*)(pr + 256 + 2 * lane);
                    const float v0 = bflo(raw), v1 = bfhi(raw);
                    const float rs = rsqrtf(wave_sum(v0 * v0 + v1 * v1) * (1.0f / 128.0f) + EPS);
                    *(LAS unsigned*)(lds + PF_AKV + tl * PF_KVP + 4 * lane) = pk2(v0 * rs * gkv[2 * lane], v1 * rs * gkv[2 * lane + 1]); }
                if (lane < 16) *(LAS unsigned*)(lds + PF_KPE + tl * 64 + 4 * lane) = *(const unsigned*)(pr + 384 + 2 * lane);
                if (lane < 36) {
                    float o[8];
                    if (lane < 8) { ps8(pr, hasprev, mu, 512 + 8 * lane, o);
#pragma unroll
                        for (int e = 0; e < 8; ++e) o[e] = 1.0f - 2.0f * __builtin_amdgcn_rcpf(1.0f + __expf(2.0f * o[e])); }
                    else if (lane < 16) { ps8(pr, hasprev, mu, 1600 + 8 * (lane - 8), o); }
                    else if (lane < 36) { ps8(pr, hasprev, mu, 1664 + 8 * (lane - 16), o);
#pragma unroll
                        for (int e = 0; e < 8; ++e) o[e] = __builtin_amdgcn_rcpf(1.0f + __expf(-o[e])); }
                    *(LAS v4u*)(lds + PF_ALA + tl * PF_LAP + 16 * lane) = pack8(o);
                }
            }
        }
        LDS_WAIT(); __syncthreads();
        LAS unsigned char* stg = lds + PF_STG + w * PF_STGW;
        const int h = w; const size_t hb = (size_t)(b * NHEAD + h) * SEQ + s0;
        if (PF_PARTS & 1) { int l15 = l15_, q = q_; asm volatile("" : "+v"(l15), "+v"(q));
            const float rfreq = __builtin_amdgcn_exp2f(-(float)l15 * (13.287712379549449f / 16.0f)) * 0.15915494309189535f;
            f32x4p acc[4][6];
#pragma unroll
            for (int m = 0; m < 4; ++m)
#pragma unroll
                for (int n = 0; n < 6; ++n) acc[m][n] = (f32x4p){0.f, 0.f, 0.f, 0.f};
            pf_mm<6, 8>(acc, lds, PF_AQ, PF_QP, 0, (const bf16*)(ws + WS_WQ), 96 * h, 256, 0, l15, q);
            const float* qn = INP(11) + l * 96; float gn[6];
#pragma unroll
            for (int n = 0; n < 6; ++n) gn[n] = qn[16 * n + l15];
            const float QSCALE = 0.10206207261596575f * 1.4426950408889634f;
            bf16* Q = (bf16*)(ws + WS_Q);
#pragma unroll
            for (int m = 0; m < 4; ++m) {
                float y[6][4];
#pragma unroll
                for (int i = 0; i < 4; ++i) { const int tl = 16 * m + 4 * q + i;
                    float ss = 0.f;
#pragma unroll
                    for (int n = 0; n < 6; ++n) ss += acc[m][n][i] * acc[m][n][i];
                    const float rs = rsqrtf(pg8::row16_sum(ss) * (1.0f / 96.0f) + EPS) * QSCALE;
                    const float rv = __builtin_amdgcn_fractf((float)(s0 + tl) * rfreq); const float cs = __builtin_amdgcn_cosf(rv), sn = __builtin_amdgcn_sinf(rv);
#pragma unroll
                    for (int n = 0; n < 6; ++n) y[n][i] = acc[m][n][i] * rs * gn[n];
                    const float r4 = y[4][i] * cs - y[5][i] * sn, r5 = y[5][i] * cs + y[4][i] * sn; y[4][i] = r4; y[5][i] = r5; }
                pf_out_bf16<6>(y, stg, Q + (hb + 16 * m) * 96, 96, lane, l15, q);
            }
        }
        asm volatile("" ::: "memory");
        if (PF_PARTS & 2) { int l15 = l15_, q = q_; asm volatile("" : "+v"(l15), "+v"(q));
            const float rfreq = __builtin_amdgcn_exp2f(-(float)l15 * (13.287712379549449f / 16.0f)) * 0.15915494309189535f;
            const float* kn = INP(12) + l * 96; float gn[6];
#pragma unroll
            for (int n = 0; n < 6; ++n) gn[n] = kn[16 * n + l15];
            bf16* K = (bf16*)(ws + WS_K); bf16* V = (bf16*)(ws + WS_V);
            {   f32x4p acc[4][4];
#pragma unroll
                for (int m = 0; m < 4; ++m)
#pragma unroll
                    for (int n = 0; n < 4; ++n) acc[m][n] = (f32x4p){0.f, 0.f, 0.f, 0.f};
                pf_mm<4, 4>(acc, lds, PF_AKV, PF_KVP, 0, (const bf16*)(ws + WS_WKV), 128 * h, 256, 0, l15, q);
#pragma unroll
                for (int m = 0; m < 4; ++m) {
                    float y[6][4];
#pragma unroll
                    for (int i = 0; i < 4; ++i) { const int tl = 16 * m + 4 * q + i;
                        const float p4 = bf2f(*(const LAS unsigned short*)(lds + PF_KPE + tl * 64 + 2 * l15)), p5 = bf2f(*(const LAS unsigned short*)(lds + PF_KPE + tl * 64 + 32 + 2 * l15));
                        float ss = p4 * p4 + p5 * p5;
#pragma unroll
                        for (int n = 0; n < 4; ++n) ss += acc[m][n][i] * acc[m][n][i];
                        const float rs = rsqrtf(pg8::row16_sum(ss) * (1.0f / 96.0f) + EPS);
                        const float rv = __builtin_amdgcn_fractf((float)(s0 + tl) * rfreq); const float cs = __builtin_amdgcn_cosf(rv), sn = __builtin_amdgcn_sinf(rv);
                        const float y4 = p4 * rs * gn[4], y5 = p5 * rs * gn[5];
#pragma unroll
                        for (int n = 0; n < 4; ++n) y[n][i] = acc[m][n][i] * rs * gn[n];
                        y[4][i] = y4 * cs - y5 * sn; y[5][i] = y5 * cs + y4 * sn; }
                    pf_out_bf16<6>(y, stg, K + (hb + 16 * m) * 96, 96, lane, l15, q);
                }
            }
            asm volatile("" ::: "memory");
            {   f32x4p acc[4][4];
#pragma unroll
                for (int m = 0; m < 4; ++m)
#pragma unroll
                    for (int n = 0; n < 4; ++n) acc[m][n] = (f32x4p){0.f, 0.f, 0.f, 0.f};
                pf_mm<4, 4>(acc, lds, PF_AKV, PF_KVP, 0, (const bf16*)(ws + WS_WKV), 128 * h + 64, 256, 0, l15, q);
#pragma unroll
                for (int m = 0; m < 4; ++m) { float y[4][4];
#pragma unroll
                    for (int n = 0; n < 4; ++n)
#pragma unroll
                        for (int i = 0; i < 4; ++i) y[n][i] = acc[m][n][i];
                    pf_out_bf16<4>(y, stg, V + (hb + 16 * m) * 64, 64, lane, l15, q); }
            }
        }
        asm volatile("" ::: "memory");
        if (PF_PARTS & 4) { int l15 = l15_, q = q_; asm volatile("" : "+v"(l15), "+v"(q));
            const float* w0 = INP(14) + l * 512; const float* a0 = INP(16) + l * 512;
            float* LW = (float*)(ws + WS_DEC); bf16* AS = (bf16*)(ws + WS_AS); bf16* G = (bf16*)(ws + WS_G);
            const bf16* WL = (const bf16*)(ws + WS_WLORA);
            {   asm volatile("" : "+v"(l15), "+v"(q)); f32x4p acc[4][4];
#pragma unroll
                for (int m = 0; m < 4; ++m)
#pragma unroll
                    for (int n = 0; n < 4; ++n) acc[m][n] = (f32x4p){0.f, 0.f, 0.f, 0.f};
                pf_mm<4, 2>(acc, lds, PF_ALA, PF_LAP, 0, WL, 64 * h, 384, 0, l15, q);
                float bw[4];
#pragma unroll
                for (int n = 0; n < 4; ++n) bw[n] = w0[64 * h + 16 * n + l15];
#pragma unroll
                for (int m = 0; m < 4; ++m) { float y[4][4];
#pragma unroll
                    for (int n = 0; n < 4; ++n)
#pragma unroll
                        for (int i = 0; i < 4; ++i) y[n][i] = -0.60653065971f * __builtin_amdgcn_rcpf(1.0f + __expf(-(acc[m][n][i] + bw[n])));
                    pf_out_f32x64(y, stg, LW + (size_t)(t0 + 16 * m) * 512 + 64 * h, 512, lane, l15, q); }
            }
            asm volatile("" ::: "memory");
            {   asm volatile("" : "+v"(l15), "+v"(q)); f32x4p acc[4][4];
#pragma unroll
                for (int m = 0; m < 4; ++m)
#pragma unroll
                    for (int n = 0; n < 4; ++n) acc[m][n] = (f32x4p){0.f, 0.f, 0.f, 0.f};
                pf_mm<4, 5>(acc, lds, PF_ALA, PF_LAP, 128, WL, 1024 + 64 * h, 384, 128, l15, q);
#pragma unroll
                for (int m = 0; m < 4; ++m) { float y[4][4];
#pragma unroll
                    for (int n = 0; n < 4; ++n)
#pragma unroll
                        for (int i = 0; i < 4; ++i) y[n][i] = acc[m][n][i];
                    pf_out_bf16<4>(y, stg, G + (size_t)(t0 + 16 * m) * 512 + 64 * h, 512, lane, l15, q); }
            }
            asm volatile("" ::: "memory");
            {   asm volatile("" : "+v"(l15), "+v"(q)); f32x4p acc[4][4];
#pragma unroll
                for (int m = 0; m < 4; ++m)
#pragma unroll
                    for (int n = 0; n < 4; ++n) acc[m][n] = (f32x4p){0.f, 0.f, 0.f, 0.f};
                pf_mm<4, 2>(acc, lds, PF_ALA, PF_LAP, 64, WL, 512 + 64 * h, 384, 64, l15, q);
                float ba[4];
#pragma unroll
                for (int n = 0; n < 4; ++n) ba[n] = a0[64 * h + 16 * n + l15];
#pragma unroll
                for (int m = 0; m < 4; ++m) { float y[4][4];
#pragma unroll
                    for (int n = 0; n < 4; ++n)
#pragma unroll
                        for (int i = 0; i < 4; ++i) y[n][i] = __builtin_amdgcn_rcpf(1.0f + __expf(-(acc[m][n][i] + ba[n])));
                    pf_out_bf16<4>(y, stg, AS + (size_t)(t0 + 16 * m) * 512 + 64 * h, 512, lane, l15, q); }
            }
            asm volatile("s_waitcnt vmcnt(0)" ::: "memory"); __syncthreads();
            {
                const float* mu = INP(13) + l * 1824; const float* k_k = INP(19) + l * 512; const float* k_a = INP(20) + l * 512; const float* r_k = INP(21) + l * 512;
                float* KN = (float*)(ws + WS_KN); float* BS = (float*)(ws + WS_BS);
                float kkc[8], kac[8], rkc[8];
#pragma unroll
                for (int e = 0; e < 8; ++e) { kkc[e] = k_k[8 * lane + e]; kac[e] = k_a[8 * lane + e]; rkc[e] = r_k[8 * lane + e]; }
#pragma unroll 2
                for (int j = 0; j < 8; ++j) {
                    const int tl = 8 * w + j; const size_t row = (size_t)t0 + tl; const bf16* pr = P + row * NINP; const bool hasprev = (s0 + tl) != 0;
                    float r[8], k[8], a[8];
                    ps8(pr, hasprev, mu, 8 * lane, r); ps8(pr, hasprev, mu, 576 + 8 * lane, k);
                    unpk8(*(const v4u*)(AS + row * 512 + 8 * lane), a);
                    float n2 = 0.f, bs = 0.f;
#pragma unroll
                    for (int e = 0; e < 8; ++e) { const float kk = k[e] * kkc[e]; n2 += kk * kk; bs += r[e] * (k[e] * (1.0f + (a[e] - 1.0f) * kac[e])) * rkc[e]; }
                    n2 = pg8::oct_sum(n2); bs = pg8::oct_sum(bs);
                    if ((lane & 7) == 0) { KN[row * 8 + (lane >> 3)] = 1.0f / fmaxf(sqrtf(n2), 1e-12f); BS[row * 8 + (lane >> 3)] = bs; }
                }
            }
        }
    }
}

constexpr int N_LAYER_PHASES = 13;
template <int PH> __global__ void __launch_bounds__(NWAVES * 64, 2) fwd(Args args) {
    extern __shared__ __attribute__((aligned(16))) unsigned char lds_raw[];
    Ctx C;
    C.lds = (LAS unsigned char*)lds_raw; C.X = args.out; C.ws = args.ws; C.ka = (const __attribute__((address_space(4))) unsigned char*)__builtin_amdgcn_kernarg_segment_ptr();
    C.G = gridDim.x; C.bid = blockIdx.x; C.wave = __builtin_amdgcn_readfirstlane(threadIdx.x >> 6);
    constexpr bool all = PH < 0;
    volatile LAS unsigned* MISC = (volatile LAS unsigned*)(C.lds + MISC_OFF);
    for (int u = threadIdx.x; u < (LDS_BYTES - RING_BYTES) / 4; u += NWAVES * 64) ((LAS unsigned*)(C.lds + RING_BYTES))[u] = 0u;
    __syncthreads();
    XcdBarrier bar; bar.bar = (unsigned*)(args.ws + WS_CTL) + 4096; bar.x = 0; bar.st = nullptr;
    if (all) bar = xcd_barrier_post((unsigned*)(args.ws + WS_CTL) + 4096, MISC + 8);
#define SEAM() do { if (all) xcd_barrier(bar); } while (0)
#define RUN(k) (all || PH == (k))
#ifndef PROBE_MASK
#define PROBE_MASK 0u
#endif
#define PROBE_HALF(k) ((((PROBE_MASK >> (k)) & 1u)) ? 0.5f : 1.0f)
#define REP(k) for (int rep_ = 0; rep_ < (((PROBE_MASK >> (k)) & 1u) ? 2 : 1); ++rep_)

    if (all || PH == 0) { ph_init(C); if (all) { ph_cvt_early0(C); SEAM(); } }
    if (!all && PH == 1) ph_cvt_early0(C);
    const int l_lo = all ? 0 : args.layer, l_hi = all ? NLAYER : args.layer + 1;
#pragma nounroll
    for (int l = l_lo; l < l_hi; ++l) {
        if (RUN(2)) REP(2) { PHASE_BASES(); float* rss = (float*)(ws + WS_RSS); bf16* XB = (bf16*)(ws + WS_XB); bf16* HB = (bf16*)(ws + WS_HB);
            pg8::Gemm g{XB, (const bf16*)(ws + WS_WGU1), MTOK, 2 * DFF, DM, DM, DM}; pg8::StaticOrder S; S.init(MTOK, 2 * DFF, P_G, P_bid);
            pg8::EpiSwiGLU E{HB, rss, DFF};
            pg8::gemm_phase<pg8::EpiSwiGLU, pg8::StaticOrder, true, true>(C.lds, g, S, E, C.wave); if (5 * P_G + P_bid >= 1408) cvt_take(C, 1, l, 2, CVT_NCH_L); SEAM();
        }
        if (RUN(3)) REP(3) { PHASE_BASES(); float* rss = (float*)(ws + WS_RSS); bf16* XB = (bf16*)(ws + WS_XB); bf16* HB = (bf16*)(ws + WS_HB);
            pg8::Gemm g{HB, (const bf16*)(ws + WS_WDN1), MTOK, DM, DFF, DFF, DFF}; pg8::StaticOrder S; S.init(MTOK, DM, P_G, P_bid);
            pg8::EpiResid E{nullptr, XB, rss, 0.5f * PROBE_HALF(3), nullptr};
            pg8::gemm_phase<pg8::EpiResid, pg8::StaticOrder, true, true>(C.lds, g, S, E, C.wave); SEAM();
        }
        if (RUN(4)) REP(4) { PHASE_BASES(); float* rss = (float*)(ws + WS_RSS); bf16* XB = (bf16*)(ws + WS_XB);
            pg8::Gemm g{XB, (const bf16*)(ws + WS_WIN), MTOK, NINP, DM, DM, DM}; pg8::StaticOrder S; S.init(MTOK, NINP, P_G, P_bid);
            pg8::EpiStore E{(bf16*)(ws + WS_P), NINP, rss};
            pg8::gemm_phase<pg8::EpiStore, pg8::StaticOrder, true, true>(C.lds, g, S, E, C.wave); if (2 * P_G + P_bid >= 576) { const int nl = cvt_take(C, 1, l, 2, CVT_NCH_L); cvt_take(C, 0, l + 1, 2 - nl, CVT_NCH_E01); } SEAM();
        }
        if (RUN(20)) { ph_prep_f(C, l);
            asm volatile("s_waitcnt vmcnt(0)" ::: "memory"); __syncthreads();
            ph_scan_a(C, l); SEAM(); }
        if (RUN(18)) { ph_mix(C, l); SEAM(); }
        if (RUN(17)) REP(17) { ph_scan_c(C, l); SEAM(); }
        if (RUN(11)) REP(11) { PHASE_BASES(); float* rss = (float*)(ws + WS_RSS); bf16* XB = (bf16*)(ws + WS_XB);
            if (P_G == 256) {
                pg8::Gemm g{(const bf16*)(ws + WS_YN), (const bf16*)(ws + WS_WOUT), MTOK, DM, DM, DM, DM}; pg8::StaticOrder S; S.init(MTOK, DM, P_G, P_bid);
                LAS float* tab = (LAS float*)(C.lds + RING_BYTES + 2048);
                { pg8::Unit u0; if (S.next(0, u0) && P_tid < 256) { const int row = u0.pm * 256 + P_tid; const float* pa = (const float*)(ws + WS_SSA) + (size_t)row * 8; const float* pr = (const float*)(ws + WS_SSR) + (size_t)row * 8;
                    const f32x4 a0 = *(const f32x4*)pa, a1 = *(const f32x4*)(pa + 4), r0 = *(const f32x4*)pr, r1 = *(const f32x4*)(pr + 4);
                    const float sa = ((a0[0] + a0[1]) + (a0[2] + a0[3])) + ((a1[0] + a1[1]) + (a1[2] + a1[3])), sr = ((r0[0] + r0[1]) + (r0[2] + r0[3])) + ((r1[0] + r1[1]) + (r1[2] + r1[3]));
                    const float ra = rsqrtf(sa * (1.0f / 512.0f) + EPS), rr = rsqrtf(sr * (1.0f / 512.0f) + EPS) * PROBE_HALF(11);
                    tab[2 * P_tid] = ra * PROBE_HALF(11) / rr; tab[2 * P_tid + 1] = rr; } }
                LDS_WAIT(); __syncthreads();
                pg8::EpiResidMid E{nullptr, XB, rss, (const LAS float*)tab};
                pg8::gemm_phase<pg8::EpiResidMid, pg8::StaticOrder, true, true>(C.lds, g, S, E, C.wave);
            }
            SEAM();
        }
        if (RUN(12)) REP(12) { PHASE_BASES(); float* rss = (float*)(ws + WS_RSS); bf16* XB = (bf16*)(ws + WS_XB); bf16* HB = (bf16*)(ws + WS_HB);
            pg8::Gemm g{XB, (const bf16*)(ws + WS_WGU2), MTOK, 2 * DFF, DM, DM, DM}; pg8::StaticOrder S; S.init(MTOK, 2 * DFF, P_G, P_bid);
            pg8::EpiSwiGLU E{HB, rss, DFF};
            pg8::gemm_phase<pg8::EpiSwiGLU, pg8::StaticOrder, true, true>(C.lds, g, S, E, C.wave); if (5 * P_G + P_bid >= 1408) { const int n0 = cvt_take(C, 0, l + 1, 2, CVT_NCH_E01); cvt_take(C, 2, l + 1, 2 - n0, CVT_NCH_E); } SEAM();
        }
        if (RUN(13)) REP(13) { PHASE_BASES(); float* rss = (float*)(ws + WS_RSS); bf16* XB = (bf16*)(ws + WS_XB); bf16* HB = (bf16*)(ws + WS_HB);
            pg8::Gemm g{HB, (const bf16*)(ws + WS_WDN2), MTOK, DM, DFF, DFF, DFF}; pg8::StaticOrder S; S.init(MTOK, DM, P_G, P_bid);
            pg8::EpiResid E{l == NLAYER - 1 ? C.X : nullptr, XB, rss, 0.5f * PROBE_HALF(13), nullptr};
            pg8::gemm_phase<pg8::EpiResid, pg8::StaticOrder, true, true>(C.lds, g, S, E, C.wave);
            cvt_drain_early(C, l + 1);
            if (l + 1 < l_hi) SEAM();
        }
    }
#undef SEAM
#undef RUN
}

template <int PH> static void launch_phase(int grid, const Args& a, hipStream_t stream) {
    static bool attr_set = false;
    if (!attr_set) { (void)hipFuncSetAttribute((const void*)fwd<PH>, hipFuncAttributeMaxDynamicSharedMemorySize, LDS_BYTES); attr_set = true; }
    hipLaunchKernelGGL(fwd<PH>, dim3(grid), dim3(NWAVES * 64), LDS_BYTES, stream, a);
}
extern "C" void kernel_launch(void* const* d_in, const int* in_sizes, int n_in, void* d_out, int out_size, void* d_ws, size_t ws_size, hipStream_t stream) {
    static int grid = 0;
    if (grid == 0) {
        if (n_in != 31 || out_size != MTOK * DM || ws_size < WS_END) { fprintf(stderr, "kernel_launch: unexpected problem (n_in %d, out %d, ws %zu < %zu); nothing launched\n", n_in, out_size, ws_size, (size_t)WS_END); grid = -1; return; }
        int dev = 0, cus = 0;
        if (hipGetDevice(&dev) != hipSuccess || hipDeviceGetAttribute(&cus, hipDeviceAttributeMultiprocessorCount, dev) != hipSuccess) { grid = -1; return; }
        grid = cus;
        if (grid != 256) { fprintf(stderr, "kernel_launch: built for a 256-CU device, found %d CUs; nothing launched\n", cus); grid = -1; return; }
    }
    if (grid < 0) return;
    (void)hipMemsetAsync((char*)d_ws + WS_CTL, 0, CTL_ZERO_BYTES, stream);
    Args a{};
    for (int i = 0; i < 31; ++i) a.in[i] = (const float*)d_in[i];
    a.out = (float*)d_out; a.ws = (unsigned char*)d_ws;
    a.layer = 0; a.ph = -1;
    launch_phase<-1>(grid, a, stream);
}
```

```cpp
#include <hip/hip_runtime.h>
#include <cstdio>
#include <cstdint>
#include <cmath>
namespace pg8 {
#define PG8_LAS __attribute__((address_space(3)))
typedef unsigned short bf16_t;
typedef short bf16x8 __attribute__((ext_vector_type(8)));
typedef float f32x4 __attribute__((ext_vector_type(4)));
typedef unsigned u32x4 __attribute__((ext_vector_type(4)));
constexpr int BM = 256, BK = 64, HALF = 128, HTB = HALF * BK * 2  , STAGE_BYTES = 8 * HTB, NXCD = 8, WGM = 8;

__host__ __device__ __forceinline__ int lds_byte(int r, int c) { const int st = (r >> 4) * 2 + (c >> 5), rr = r & 15, cc = c & 31, ob = rr * 64 + cc * 2; return st * 1024 + (ob ^ (((ob >> 9) & 1) << 5)); }
__host__ __device__ __forceinline__ void stage_rc(int b, int& R, int& C) { const int st = b / 1024, sb = b % 1024, swz = sb ^ (((sb >> 9) & 1) << 5); R = (st >> 1) * 16 + swz / 64; C = (st & 1) * 32 + (swz % 64) / 2; }
__host__ __device__ __forceinline__ int perm32(int rho) { const int n = rho >> 4, i = rho & 15; return 8 * (i >> 2) + 4 * n + (i & 3); }

struct Unit { int pm, pn; };
struct Gemm { const bf16_t* A; const bf16_t* Bt; int M, N, K, lda, ldb; };

struct StaticOrder {
    int nM, nN, nwg, G, c;
    __host__ __device__ __forceinline__ void init(int M, int N, int G_, int c_) { nM = M / BM; nN = N / BM; nwg = nM * nN; G = G_; c = c_; }
    __host__ __device__ __forceinline__ bool next(int i, Unit& u) const {
        const long L = (long)i * G + c; if (L >= nwg) return false;
        int wgid = (int)L; { const int q = nwg / NXCD, r = nwg % NXCD, xcd = wgid % NXCD, off = wgid / NXCD; wgid = (xcd < r ? xcd * (q + 1) : r * (q + 1) + (xcd - r) * q) + off; }
        const int nig = WGM * nN, gid = wgid / nig, fm = gid * WGM, gsz = (nM - fm) < WGM ? (nM - fm) : WGM;
        u.pm = fm + ((wgid % nig) % gsz); u.pn = (wgid % nig) / gsz; return true;
    }
    __device__ __forceinline__ void a_ready(const Unit&) const {}
    __device__ __forceinline__ void done(const Unit&) const {}
};
typedef __bf16 pg8_nbf16x2_t __attribute__((ext_vector_type(2)));
typedef float pg8_nf32x2_t __attribute__((ext_vector_type(2)));
__device__ __forceinline__ unsigned cvt_pk_bf16(float lo, float hi) { return __builtin_bit_cast(unsigned, __builtin_convertvector((pg8_nf32x2_t){lo, hi}, pg8_nbf16x2_t)); }
typedef float f32x2 __attribute__((ext_vector_type(2)));
typedef unsigned u32x2 __attribute__((ext_vector_type(2)));
template <int K> __device__ __forceinline__ float swz_xor(float v) { return __builtin_bit_cast(float, __builtin_amdgcn_ds_swizzle(__builtin_bit_cast(int, v), (K << 10) | 0x1f)); }
template <int CTRL> __device__ __forceinline__ float dpp_mov(float v) { return __builtin_bit_cast(float, __builtin_amdgcn_update_dpp(0, __builtin_bit_cast(int, v), CTRL, 0xf, 0xf, false)); }
__device__ __forceinline__ float row16_sum(float v) { v += dpp_mov<0x128>(v); v += dpp_mov<0x124>(v); v += dpp_mov<0x122>(v); v += dpp_mov<0x121>(v); return v; }
__device__ __forceinline__ float oct_sum(float v) { v += dpp_mov<0xB1>(v); v += dpp_mov<0x4E>(v); v += dpp_mov<0x141>(v); return v; }
__device__ __forceinline__ void x32_pair(float v, float& a, float& b) {
    unsigned u0 = __builtin_bit_cast(unsigned, v), u1 = u0; asm volatile("" : "+v"(u1));
    const auto rr = __builtin_amdgcn_permlane32_swap(u0, u1, false, false);
    unsigned r0 = rr[0], r1 = rr[1]; asm volatile("" : "+v"(r0), "+v"(r1));
    a = __builtin_bit_cast(float, r0); b = __builtin_bit_cast(float, r1);
}
__device__ __forceinline__ float sum_x32(float v) { float a, b; x32_pair(v, a, b); return a + b; }
__device__ __forceinline__ float max_x32(float v) { float a, b; x32_pair(v, a, b); return fmaxf(a, b); }
__device__ __forceinline__ float row_rstd(const float* rss, int row, int fq) {
    const f32x4 v = *(const f32x4*)(rss + (size_t)row * 16 + 4 * fq);
    float s = (v[0] + v[1]) + (v[2] + v[3]);
    s += swz_xor<16>(s); s = sum_x32(s);
    return rsqrtf(s * (1.0f / 1024.0f) + 1e-6f);
}
__device__ __forceinline__ float silu_mul(float g, float u) { return g * __builtin_amdgcn_rcpf(1.0f + __expf(-g)) * u; }
struct EpiSwiGLU {
    static constexpr bool PERM = true, AFTER_DRAIN = false, MID = false;
    bf16_t* H; const float* rss; int ldh;
    __device__ __forceinline__ void operator()(const f32x4 (&acc)[2][2][4][2], const Unit& u, int wr, int wc, int fr_in, int fq_in) const {
        int ln_; asm volatile("v_mbcnt_lo_u32_b32 %0, -1, 0\n\tv_mbcnt_hi_u32_b32 %0, -1, %0" : "=v"(ln_)); const int fr = ln_ & 15, fq = ln_ >> 4; (void)fr_in; (void)fq_in;
        const int col0 = u.pn * 128 + wc * 32 + 8 * fq;
#pragma unroll
        for (int ai = 0; ai < 2; ++ai)
#pragma unroll
            for (int m = 0; m < 4; ++m) {
                const int row = u.pm * BM + ai * HALF + wr * 64 + m * 16 + fr;
                const float rs = row_rstd(rss, row, fq);
                const float s2 = rs * -1.4426950408889634f, rs2 = rs * rs;
                const f32x4 t0 = acc[ai][0][m][0] * s2, t1 = acc[ai][0][m][1] * s2;
                float e[8], r[8];
#pragma unroll
                for (int j = 0; j < 4; ++j) { e[j] = __builtin_amdgcn_exp2f(t0[j]); e[4 + j] = __builtin_amdgcn_exp2f(t1[j]); }
#pragma unroll
                for (int j = 0; j < 8; ++j) r[j] = __builtin_amdgcn_rcpf(1.0f + e[j]);
                const f32x4 h0 = (acc[ai][0][m][0] * acc[ai][1][m][0]) * rs2, h1 = (acc[ai][0][m][1] * acc[ai][1][m][1]) * rs2;
                u32x4 w;
                w.x = cvt_pk_bf16(h0[0] * r[0], h0[1] * r[1]);
                w.y = cvt_pk_bf16(h0[2] * r[2], h0[3] * r[3]);
                w.z = cvt_pk_bf16(h1[0] * r[4], h1[1] * r[5]);
                w.w = cvt_pk_bf16(h1[2] * r[6], h1[3] * r[7]);
                *(u32x4*)(H + (size_t)row * ldh + col0) = w;
                asm volatile("" ::: "memory");
            }
    }
};
template <bool WRITE_XB> struct EpiResidT {
    static constexpr bool PERM = true, AFTER_DRAIN = false, MID = false;
    float* X; bf16_t* XB; float* rss; float alpha; const float* ss;
    __device__ __forceinline__ void operator()(const f32x4 (&acc)[2][2][4][2], const Unit& u, int wr, int wc, int fr_in, int fq_in) const {
        int ln_; asm volatile("v_mbcnt_lo_u32_b32 %0, -1, 0\n\tv_mbcnt_hi_u32_b32 %0, -1, %0" : "=v"(ln_)); const int fr = ln_ & 15, fq = ln_ >> 4; (void)fr_in; (void)fq_in;
        const int col0 = u.pn * BM + wc * 32 + 8 * fq;
#pragma unroll
        for (int ai = 0; ai < 2; ++ai)
#pragma unroll
            for (int m = 0; m < 4; ++m) {
                const int row = u.pm * BM + ai * HALF + wr * 64 + m * 16 + fr;
                float sc = alpha;
                if (ss) { const f32x4 pv = *(const f32x4*)(ss + (size_t)row * 8 + 4 * (fq & 1)); float t = (pv[0] + pv[1]) + (pv[2] + pv[3]); t += swz_xor<16>(t); sc = alpha * rsqrtf(t * (1.0f / 512.0f) + 1e-6f); }
                float sq = 0.f;
#pragma unroll
                for (int bj = 0; bj < 2; ++bj) {
                    const size_t off = (size_t)row * 1024 + col0 + bj * HALF;
                    const u32x4 xr = *(const u32x4*)(XB + off);
                    f32x4 x0, x1;
                    x0[0] = __builtin_bit_cast(float, xr.x << 16); x0[1] = __builtin_bit_cast(float, xr.x & 0xffff0000u); x0[2] = __builtin_bit_cast(float, xr.y << 16); x0[3] = __builtin_bit_cast(float, xr.y & 0xffff0000u);
                    x1[0] = __builtin_bit_cast(float, xr.z << 16); x1[1] = __builtin_bit_cast(float, xr.z & 0xffff0000u); x1[2] = __builtin_bit_cast(float, xr.w << 16); x1[3] = __builtin_bit_cast(float, xr.w & 0xffff0000u);
                    x0 = x0 + acc[ai][bj][m][0] * sc; x1 = x1 + acc[ai][bj][m][1] * sc;
                    if (X) { *(f32x4*)(X + off) = x0; *(f32x4*)(X + off + 4) = x1; }
                    if (WRITE_XB) { u32x4 w; w.x = cvt_pk_bf16(x0[0], x0[1]); w.y = cvt_pk_bf16(x0[2], x0[3]); w.z = cvt_pk_bf16(x1[0], x1[1]); w.w = cvt_pk_bf16(x1[2], x1[3]); *(u32x4*)(XB + off) = w;
                        sq += ((x0[0] * x0[0] + x0[1] * x0[1]) + (x0[2] * x0[2] + x0[3] * x0[3])) + ((x1[0] * x1[0] + x1[1] * x1[1]) + (x1[2] * x1[2] + x1[3] * x1[3])); }
                }
                if (WRITE_XB) { sq += swz_xor<16>(sq); sq = sum_x32(sq); if (fq == 0) rss[(size_t)row * 16 + u.pn * 4 + wc] = sq; }
                if (m & 1) asm volatile("" ::: "memory");
            }
    }
};
typedef EpiResidT<true> EpiResid;
struct EpiResidMid {
    static constexpr bool PERM = true, AFTER_DRAIN = false, MID = true;
    float* X; bf16_t* XB; float* rss; const PG8_LAS float* tab;
    __device__ __forceinline__ void mid(f32x4 (&acc)[2][2][4][2], int wr) const {
        int ln_; asm volatile("v_mbcnt_lo_u32_b32 %0, -1, 0\n\tv_mbcnt_hi_u32_b32 %0, -1, %0" : "=v"(ln_)); const int fr = ln_ & 15;
#pragma unroll
        for (int ai = 0; ai < 2; ++ai)
#pragma unroll
            for (int m = 0; m < 4; ++m) { const float r = tab[2 * (ai * HALF + wr * 64 + m * 16 + fr)];
#pragma unroll
                for (int bj = 0; bj < 2; ++bj)
#pragma unroll
                    for (int n = 0; n < 2; ++n) acc[ai][bj][m][n] = acc[ai][bj][m][n] * r; }
    }
    __device__ __forceinline__ void operator()(const f32x4 (&acc)[2][2][4][2], const Unit& u, int wr, int wc, int fr_in, int fq_in) const {
        int ln_; asm volatile("v_mbcnt_lo_u32_b32 %0, -1, 0\n\tv_mbcnt_hi_u32_b32 %0, -1, %0" : "=v"(ln_)); const int fr = ln_ & 15, fq = ln_ >> 4; (void)fr_in; (void)fq_in;
#pragma unroll
        for (int ai = 0; ai < 2; ++ai)
#pragma unroll
            for (int m = 0; m < 4; ++m) {
                const int lr = ai * HALF + wr * 64 + m * 16 + fr, row = u.pm * BM + lr;
                const float sc = tab[2 * lr + 1];
                float sq = 0.f;
#pragma unroll
                for (int bj = 0; bj < 2; ++bj) {
                    const size_t off = (size_t)row * 1024 + u.pn * BM + wc * 32 + 8 * fq + bj * HALF;
                    const u32x4 xr = *(const u32x4*)(XB + off);
                    f32x4 x0, x1;
                    x0[0] = __builtin_bit_cast(float, xr.x << 16); x0[1] = __builtin_bit_cast(float, xr.x & 0xffff0000u); x0[2] = __builtin_bit_cast(float, xr.y << 16); x0[3] = __builtin_bit_cast(float, xr.y & 0xffff0000u);
                    x1[0] = __builtin_bit_cast(float, xr.z << 16); x1[1] = __builtin_bit_cast(float, xr.z & 0xffff0000u); x1[2] = __builtin_bit_cast(float, xr.w << 16); x1[3] = __builtin_bit_cast(float, xr.w & 0xffff0000u);
                    x0 = x0 + acc[ai][bj][m][0] * sc; x1 = x1 + acc[ai][bj][m][1] * sc;
                    u32x4 w; w.x = cvt_pk_bf16(x0[0], x0[1]); w.y = cvt_pk_bf16(x0[2], x0[3]); w.z = cvt_pk_bf16(x1[0], x1[1]); w.w = cvt_pk_bf16(x1[2], x1[3]); *(u32x4*)(XB + off) = w;
                    sq += ((x0[0] * x0[0] + x0[1] * x0[1]) + (x0[2] * x0[2] + x0[3] * x0[3])) + ((x1[0] * x1[0] + x1[1] * x1[1]) + (x1[2] * x1[2] + x1[3] * x1[3]));
                }
                sq += swz_xor<16>(sq); sq = sum_x32(sq); if (fq == 0) rss[(size_t)row * 16 + u.pn * 4 + wc] = sq;
                if (m & 1) asm volatile("" ::: "memory");
            }
    }
};
struct EpiStore {
    static constexpr bool PERM = true, AFTER_DRAIN = false, MID = false;
    bf16_t* O; int ldc; const float* rss;
    __device__ __forceinline__ void operator()(const f32x4 (&acc)[2][2][4][2], const Unit& u, int wr, int wc, int fr_in, int fq_in) const {
        int ln_; asm volatile("v_mbcnt_lo_u32_b32 %0, -1, 0\n\tv_mbcnt_hi_u32_b32 %0, -1, %0" : "=v"(ln_)); const int fr = ln_ & 15, fq = ln_ >> 4; (void)fr_in; (void)fq_in;
        const int col0 = u.pn * BM + wc * 32 + 8 * fq;
#pragma unroll
        for (int ai = 0; ai < 2; ++ai)
#pragma unroll
            for (int m = 0; m < 4; ++m) {
                const int row = u.pm * BM + ai * HALF + wr * 64 + m * 16 + fr;
                const float rs = rss ? row_rstd(rss, row, fq) : 1.0f;
#pragma unroll
                for (int bj = 0; bj < 2; ++bj) {
                    const f32x4 v0 = acc[ai][bj][m][0] * rs, v1 = acc[ai][bj][m][1] * rs;
                    u32x4 w; w.x = cvt_pk_bf16(v0[0], v0[1]); w.y = cvt_pk_bf16(v0[2], v0[3]); w.z = cvt_pk_bf16(v1[0], v1[1]); w.w = cvt_pk_bf16(v1[2], v1[3]);
                    *(u32x4*)(O + (size_t)row * ldc + col0 + bj * HALF) = w;
                }
                asm volatile("" ::: "memory");
            }
    }
};
struct EpiLora {
    static constexpr bool PERM = true, AFTER_DRAIN = false, MID = false;
    float* DEC; bf16_t* AS; bf16_t* G; const float* w0; const float* a0;
    __device__ __forceinline__ void operator()(const f32x4 (&acc)[2][2][4][2], const Unit& u, int wr, int wc, int fr_in, int fq_in) const {
        int ln_; asm volatile("v_mbcnt_lo_u32_b32 %0, -1, 0\n\tv_mbcnt_hi_u32_b32 %0, -1, %0" : "=v"(ln_)); const int fr = ln_ & 15, fq = ln_ >> 4; (void)fr_in; (void)fq_in;
        const int which = u.pn >> 1, cb = (u.pn & 1) * BM + wc * 32 + 8 * fq;
        const float* bias = (which == 0) ? w0 : a0; const float bsc = (which == 2) ? 0.f : 1.f;
        bf16_t* ob = (which == 1) ? AS : G;
#pragma unroll
        for (int ai = 0; ai < 2; ++ai)
#pragma unroll
            for (int m = 0; m < 4; ++m) {
                const int row = u.pm * BM + ai * HALF + wr * 64 + m * 16 + fr;
#pragma unroll
                for (int bj = 0; bj < 2; ++bj) {
                    const size_t off = (size_t)row * 512 + cb + bj * HALF;
                    const float* bp = bias + cb + bj * HALF;
                    f32x4 v0 = acc[ai][bj][m][0] + *(const f32x4*)bp * bsc, v1 = acc[ai][bj][m][1] + *(const f32x4*)(bp + 4) * bsc;
                    f32x4 s0, s1, d0, d1;
#pragma unroll
                    for (int e = 0; e < 4; ++e) { s0[e] = __builtin_amdgcn_rcpf(1.0f + __expf(-v0[e])); s1[e] = __builtin_amdgcn_rcpf(1.0f + __expf(-v1[e])); d0[e] = -0.60653065971f * s0[e]; d1[e] = -0.60653065971f * s1[e]; }
                    if (which == 0) { *(f32x4*)(DEC + off) = d0; *(f32x4*)(DEC + off + 4) = d1; }
                    else {
                        if (which == 1) { v0 = s0; v1 = s1; }
                        u32x4 w; w.x = cvt_pk_bf16(v0[0], v0[1]); w.y = cvt_pk_bf16(v0[2], v0[3]); w.z = cvt_pk_bf16(v1[0], v1[1]); w.w = cvt_pk_bf16(v1[2], v1[3]);
                        *(u32x4*)(ob + off) = w;
                    }
                }
                asm volatile("" ::: "memory");
            }
    }
};
template <class Epi, class Sched, bool ALIGN_EPI = false, bool SP2 = false>
__device__ __forceinline__ void gemm_phase(PG8_LAS unsigned char* lds, const Gemm g, const Sched& S, const Epi& E, const int wid_in  ) {
    int lane_; asm volatile("v_mbcnt_lo_u32_b32 %0, -1, 0\n\tv_mbcnt_hi_u32_b32 %0, -1, %0" : "=v"(lane_));
    int wid_ = wid_in; asm volatile("" : "+s"(wid_));
    const int wid = wid_, lane = lane_, tid = wid * 64 + lane, wr = wid >> 2, wc = wid & 3, fr = lane & 15, fq = lane >> 4;
    const int K = g.K, nt = K / BK;
    unsigned voffA[2], voffB[2];
#pragma unroll
    for (int i = 0; i < 2; ++i) { int R, C; stage_rc(tid * 16 + i * 8192, R, C); const int Rb = Epi::PERM ? ((R & ~31) + perm32(R & 31)) : R;
        voffA[i] = (unsigned)(R * g.lda + C) * 2u; voffB[i] = (unsigned)(Rb * g.ldb + C) * 2u; }
    const size_t kstep = (size_t)(BK * 2);
    const size_t hstepA = (size_t)HALF * g.lda * 2, hstepB = (size_t)HALF * g.ldb * 2;
    const size_t tstepA = 2 * hstepA, tstepB = 2 * hstepB;
    const unsigned ldsw = (unsigned)wid * 1024u;
    const int aoff = lds_byte(wr * 64 + fr, fq * 8), boff = lds_byte(wc * 32 + fr, fq * 8);
#define PG8_SA(b, h) (((b) * 2 + (h)) * HTB)
#define PG8_SB(b, h) ((4 + (b) * 2 + (h)) * HTB)
#define PG8_STAGE(bufoff, gbase, voff) do { _Pragma("unroll") for (int _i = 0; _i < 2; ++_i) \
        __builtin_amdgcn_global_load_lds((const unsigned*)((const char*)(gbase) + (voff)[_i]), (PG8_LAS unsigned*)(lds + (bufoff) + ldsw + _i * 8192), 16, 0, 0); } while (0)
#define PG8_LDA(dst, b, h) do { _Pragma("unroll") for (int m = 0; m < 4; ++m) _Pragma("unroll") for (int k = 0; k < 2; ++k) dst[m][k] = *(const PG8_LAS bf16x8*)(lds + PG8_SA(b, h) + aoff + m * 2048 + k * 1024); } while (0)
#define PG8_LDB(dst, b, h) do { _Pragma("unroll") for (int n = 0; n < 2; ++n) _Pragma("unroll") for (int k = 0; k < 2; ++k) dst[n][k] = *(const PG8_LAS bf16x8*)(lds + PG8_SB(b, h) + boff + n * 2048 + k * 1024); } while (0)
#define PG8_MMA(ai, bj, At, Bt) do { __builtin_amdgcn_s_setprio(1); _Pragma("unroll") for (int m = 0; m < 4; ++m) _Pragma("unroll") for (int n = 0; n < 2; ++n) _Pragma("unroll") for (int k = 0; k < 2; ++k) \
        acc[ai][bj][m][n] = __builtin_amdgcn_mfma_f32_16x16x32_bf16(Bt[n][k], At[m][k], acc[ai][bj][m][n], 0, 0, 0); __builtin_amdgcn_s_setprio(0); } while (0)
#define PG8_WAIT_V(n) asm volatile("s_waitcnt vmcnt(" #n ")" ::: "memory")
#define PG8_WAIT_L(n) asm volatile("s_waitcnt lgkmcnt(" #n ")" ::: "memory")
#define PG8_BAR __builtin_amdgcn_s_barrier()
#define PG8_SCHED __builtin_amdgcn_sched_barrier(0)
    Unit cur, nxt; int ui = 0;
    if (!S.next(0, cur)) return;
    f32x4 acc[2][2][4][2];
#pragma unroll
    for (int a = 0; a < 2; ++a)
#pragma unroll
        for (int b = 0; b < 2; ++b)
#pragma unroll
            for (int m = 0; m < 4; ++m)
#pragma unroll
                for (int n = 0; n < 2; ++n) acc[a][b][m][n] = (f32x4){0.f, 0.f, 0.f, 0.f};
    bf16x8 At[4][2], B0[2][2], B1[2][2];
    const char* cA = (const char*)g.A + (size_t)cur.pm * tstepA; const char* cB = (const char*)g.Bt + (size_t)cur.pn * tstepB;
    S.a_ready(cur);
    if constexpr (SP2) {
        PG8_STAGE(PG8_SB(0, 0), cB, voffB); PG8_STAGE(PG8_SB(0, 1), cB + hstepB, voffB); PG8_STAGE(PG8_SA(0, 0), cA, voffA); PG8_STAGE(PG8_SA(0, 1), cA + hstepA, voffA);
        if (wr == 1) PG8_BAR;
        PG8_WAIT_V(2); PG8_BAR;
        PG8_STAGE(PG8_SB(1, 0), cB + kstep, voffB); PG8_STAGE(PG8_SA(1, 0), cA + kstep, voffA); PG8_STAGE(PG8_SB(1, 1), cB + hstepB + kstep, voffB);
        PG8_WAIT_V(6); PG8_BAR;
    } else {
        PG8_STAGE(PG8_SB(0, 0), cB, voffB); PG8_STAGE(PG8_SA(0, 0), cA, voffA); PG8_STAGE(PG8_SB(0, 1), cB + hstepB, voffB); PG8_STAGE(PG8_SA(0, 1), cA + hstepA, voffA);
        if (wr == 1) PG8_BAR;
        PG8_WAIT_V(4); PG8_BAR;
        PG8_STAGE(PG8_SB(1, 0), cB + kstep, voffB); PG8_STAGE(PG8_SA(1, 0), cA + kstep, voffA); PG8_STAGE(PG8_SB(1, 1), cB + hstepB + kstep, voffB);
        PG8_WAIT_V(6); PG8_BAR;
    }
    for (;;) {
        const bool has_next = S.next(ui + 1, nxt);
        const char* nA = has_next ? (const char*)g.A + (size_t)nxt.pm * tstepA : cA; const char* nB = has_next ? (const char*)g.Bt + (size_t)nxt.pn * tstepB : cB;
        for (int th = 0; th < (Epi::MID ? 2 : 1); ++th) {
        if constexpr (Epi::MID) { if (th == 1) E.mid(acc, wr); }
        const int t_lo = Epi::MID ? th * (nt >> 1) : 0, t_hi = Epi::MID ? (th + 1) * (nt >> 1) : nt;
        for (int t = t_lo; t < t_hi; t += 2) {
            const bool last = (t == nt - 2);
            const char* a1 = cA + (size_t)(t + 1) * kstep;
            const char* a2 = last ? nA : cA + (size_t)(t + 2) * kstep; const char* b2 = last ? nB : cB + (size_t)(t + 2) * kstep;
            const char* a3 = a2 + kstep; const char* b3 = b2 + kstep;
            if (last && has_next) S.a_ready(nxt);
            if constexpr (SP2) {
            PG8_LDB(B0, 0, 0); PG8_LDB(B1, 0, 1); PG8_SCHED; PG8_LDA(At, 0, 0); PG8_STAGE(PG8_SA(1, 1), a1 + hstepA, voffA);
            PG8_WAIT_V(8); PG8_WAIT_L(0); PG8_BAR; PG8_MMA(0, 0, At, B0); PG8_MMA(0, 1, At, B1); PG8_BAR; PG8_SCHED;
            PG8_LDA(At, 0, 1); PG8_STAGE(PG8_SB(0, 0), b2, voffB); PG8_STAGE(PG8_SB(0, 1), b2 + hstepB, voffB); PG8_STAGE(PG8_SA(0, 0), a2, voffA);
            PG8_WAIT_V(8); PG8_WAIT_L(0); PG8_BAR; PG8_MMA(1, 0, At, B0); PG8_MMA(1, 1, At, B1); PG8_BAR; PG8_SCHED;
            PG8_LDB(B0, 1, 0); PG8_LDB(B1, 1, 1); PG8_SCHED; PG8_LDA(At, 1, 0); PG8_STAGE(PG8_SA(0, 1), a2 + hstepA, voffA);
            PG8_WAIT_V(8); PG8_WAIT_L(0); PG8_BAR; PG8_MMA(0, 0, At, B0); PG8_MMA(0, 1, At, B1); PG8_BAR; PG8_SCHED;
            PG8_LDA(At, 1, 1); PG8_STAGE(PG8_SB(1, 0), b3, voffB); PG8_STAGE(PG8_SB(1, 1), b3 + hstepB, voffB); PG8_STAGE(PG8_SA(1, 0), a3, voffA);
            PG8_WAIT_V(8); PG8_WAIT_L(0); PG8_BAR; PG8_MMA(1, 0, At, B0); PG8_MMA(1, 1, At, B1); PG8_BAR; PG8_SCHED;
            } else {
            PG8_LDB(B0, 0, 0); PG8_SCHED; PG8_LDA(At, 0, 0); PG8_STAGE(PG8_SA(1, 1), a1 + hstepA, voffA);
            PG8_WAIT_L(8); PG8_BAR; PG8_WAIT_L(0); PG8_MMA(0, 0, At, B0); PG8_BAR; PG8_SCHED;
            PG8_LDB(B1, 0, 1); PG8_STAGE(PG8_SB(0, 0), b2, voffB);
            PG8_BAR; PG8_WAIT_L(0); PG8_MMA(0, 1, At, B1); PG8_BAR;
            PG8_LDA(At, 0, 1); PG8_STAGE(PG8_SA(0, 0), a2, voffA);
            PG8_BAR; PG8_WAIT_L(0); PG8_MMA(1, 0, At, B0); PG8_BAR; PG8_SCHED;
            PG8_STAGE(PG8_SB(0, 1), b2 + hstepB, voffB);
            PG8_WAIT_V(6); PG8_BAR; PG8_MMA(1, 1, At, B1); PG8_BAR;
            PG8_LDB(B0, 1, 0); PG8_SCHED; PG8_LDA(At, 1, 0); PG8_STAGE(PG8_SA(0, 1), a2 + hstepA, voffA);
            PG8_WAIT_L(8); PG8_BAR; PG8_WAIT_L(0); PG8_MMA(0, 0, At, B0); PG8_BAR; PG8_SCHED;
            PG8_LDB(B1, 1, 1); PG8_STAGE(PG8_SB(1, 0), b3, voffB);
            PG8_BAR; PG8_WAIT_L(0); PG8_MMA(0, 1, At, B1); PG8_BAR;
            PG8_LDA(At, 1, 1); PG8_STAGE(PG8_SA(1, 0), a3, voffA);
            PG8_BAR; PG8_WAIT_L(0); PG8_MMA(1, 0, At, B0); PG8_BAR; PG8_SCHED;
            PG8_STAGE(PG8_SB(1, 1), b3 + hstepB, voffB);
            PG8_WAIT_V(6); PG8_BAR; PG8_MMA(1, 1, At, B1); PG8_BAR;
            }
        }
        }
        if constexpr (ALIGN_EPI) { if (wr == 0) PG8_BAR; }
        if constexpr (!Epi::AFTER_DRAIN) { E(acc, cur, wr, wc, fr, fq); S.done(cur); }
        if (!has_next) break;
#pragma unroll
        for (int a = 0; a < 2; ++a)
#pragma unroll
            for (int b = 0; b < 2; ++b)
#pragma unroll
                for (int m = 0; m < 4; ++m)
#pragma unroll
                    for (int n = 0; n < 2; ++n) acc[a][b][m][n] = (f32x4){0.f, 0.f, 0.f, 0.f};
        cur = nxt; cA = nA; cB = nB; ++ui;
        if constexpr (ALIGN_EPI) { if (wr == 1) PG8_BAR; }
    }
    PG8_WAIT_V(0);
    if constexpr (!ALIGN_EPI) { if (wr == 0) PG8_BAR; }
    PG8_BAR;
    if constexpr (Epi::AFTER_DRAIN) { E.fused(acc, cur, wr, wc, fr, fq, lds, wid, lane); S.done(cur); }
#undef PG8_SA
#undef PG8_SB
#undef PG8_STAGE
#undef PG8_LDA
#undef PG8_LDB
#undef PG8_MMA
#undef PG8_WAIT_V
#undef PG8_WAIT_L
#undef PG8_BAR
#undef PG8_SCHED
}
}

constexpr int NWAVES = 8;
constexpr int NB = 4, SEQ = 4096, DM = 1024, DFF = 2816, NLAYER = 4;
constexpr int MTOK = NB * SEQ;
constexpr int NIN = 2240, NINP = 2304;
constexpr int NHEAD = 8, DQK = 96, DV = 64;
constexpr float EPS = 1e-6f;
constexpr int RW_OFF = 416;
constexpr size_t MiB = 1u << 20;
constexpr size_t WS_CTL = 0, CTL_ZERO_BYTES = 32 * 1024;
constexpr size_t WS_RSS = 1 * MiB;
constexpr size_t WS_WGU1 = 2 * MiB, WS_WDN1 = 13 * MiB, WS_WGU2 = 19 * MiB, WS_WDN2 = 30 * MiB, WS_WIN = 36 * MiB, WS_WOUT = 41 * MiB;
constexpr size_t WS_WQ = 43 * MiB, WS_WKV = WS_WQ + 512 * 1024, WS_WLORA = 44 * MiB;
constexpr size_t WS_XB = 46 * MiB;
constexpr size_t R1 = 78 * MiB;
constexpr size_t WS_HB = R1;
constexpr size_t WS_P = R1;
constexpr size_t WS_QLN = R1 + 72 * MiB, WS_KVLN = R1 + 80 * MiB, WS_LA = R1 + 88 * MiB;
constexpr size_t WS_K = R1 + 72 * MiB;
constexpr size_t WS_AS = R1 + 100 * MiB;
constexpr size_t WS_DEC = R1 + 116 * MiB;
constexpr size_t WS_SHS = R1 + 116 * MiB;
constexpr size_t WS_G = R1 + 148 * MiB;
constexpr size_t WS_QRAW = R1 + 164 * MiB, WS_KVRAW = R1 + 188 * MiB;
constexpr size_t WS_SP = R1 + 164 * MiB, WS_SQT = R1 + 180 * MiB, WS_SRH = R1 + 196 * MiB, WS_SYVT = R1 + 212 * MiB;
constexpr size_t WS_Q = R1 + 228 * MiB, WS_V = R1 + 252 * MiB;
constexpr size_t WS_YN = R1 + 268 * MiB;
constexpr size_t WS_KPE = R1 + 300 * MiB;
constexpr size_t WS_KN = R1 + 301 * MiB + 1536 * 1024;
constexpr size_t WS_BS = R1 + 301 * MiB, WS_SSA = WS_BS + 512 * 1024, WS_SSR = WS_BS + 1024 * 1024;
constexpr size_t WS_END = R1 + 303 * MiB;
constexpr size_t WS_ROPE = 512 * 1024;
constexpr int RING_BYTES = 131072;
constexpr int MISC_OFF = RING_BYTES + 320;
constexpr int LDS_BYTES = 147456;

#define GAS __attribute__((address_space(1)))
#define LAS __attribute__((address_space(3)))
typedef unsigned short bf16;
typedef unsigned v4u __attribute__((ext_vector_type(4)));
typedef unsigned v2u __attribute__((ext_vector_type(2)));
typedef float f32x4 __attribute__((ext_vector_type(4)));
typedef float f32x16 __attribute__((ext_vector_type(16)));
typedef short bf16x8 __attribute__((ext_vector_type(8)));
typedef short s16x4 __attribute__((ext_vector_type(4)));
typedef GAS unsigned gu32;
#define RLX_AGENT __ATOMIC_RELAXED, __HIP_MEMORY_SCOPE_AGENT
#define LDS_WAIT() asm volatile("s_waitcnt lgkmcnt(0)" ::: "memory")
typedef __bf16 nbf16x2_t __attribute__((ext_vector_type(2)));
typedef float nf32x2_t __attribute__((ext_vector_type(2)));
__device__ __forceinline__ unsigned pk2(float lo, float hi) { return __builtin_bit_cast(unsigned, __builtin_convertvector((nf32x2_t){lo, hi}, nbf16x2_t)); }
__device__ __forceinline__ unsigned f2bf(float f) { return (unsigned)__builtin_bit_cast(unsigned short, (__bf16)f); }
__device__ __forceinline__ float bf2f(unsigned short b) { return __builtin_bit_cast(float, (unsigned)b << 16); }
__device__ __forceinline__ float bflo(unsigned w) { return __builtin_bit_cast(float, w << 16); }
__device__ __forceinline__ float bfhi(unsigned w) { return __builtin_bit_cast(float, w & 0xffff0000u); }
__device__ __forceinline__ float wave_sum(float v) {
    v = pg8::row16_sum(v);
    const int u = __builtin_bit_cast(int, v);
    const float a = __builtin_bit_cast(float, __builtin_amdgcn_readlane(u, 0)), b = __builtin_bit_cast(float, __builtin_amdgcn_readlane(u, 16));
    const float c = __builtin_bit_cast(float, __builtin_amdgcn_readlane(u, 32)), d = __builtin_bit_cast(float, __builtin_amdgcn_readlane(u, 48));
    return (a + b) + (c + d);
}
#define XB_TMO      128
#define XB_XCNT(j)  (256  + 64 * (j))
#define XB_XSUB(j)  (1280 + 64 * (j))
#define XB_XGEN(j)  (2304 + 64 * (j))
#define XB_TOP      3328
#define XB_TOPGEN   3392
#define XCD_BAR_WORDS 3456
#define XB_SPIN_CAP (1u << 21)

__device__ __forceinline__ unsigned xb_ld(unsigned* p)              { return __hip_atomic_load(p, __ATOMIC_RELAXED, __HIP_MEMORY_SCOPE_AGENT); }
__device__ __forceinline__ unsigned xb_add(unsigned* p, unsigned v) { return __hip_atomic_fetch_add(p, v, __ATOMIC_RELAXED, __HIP_MEMORY_SCOPE_AGENT); }
__device__ __forceinline__ unsigned xb_xcc_id() { return (unsigned)__builtin_amdgcn_s_getreg((3 << 11) | 20) & 0xFu; }
#define XB_SPIN(cond, bar) do { unsigned _sp = 0; while (cond) { __builtin_amdgcn_s_sleep(1); \
    if ((++_sp & 255u) == 0u) { if (xb_ld(&(bar)[XB_TMO])) break; if (_sp > XB_SPIN_CAP) { atomicAdd(&(bar)[XB_TMO], 1u); break; } } } } while (0)

struct XcdBarrier {
    unsigned* bar; unsigned x;
    volatile LAS unsigned* st;
};

__device__ __forceinline__ XcdBarrier xcd_barrier_post(unsigned* bar, volatile LAS unsigned* st) {
    XcdBarrier b; b.bar = bar; b.x = xb_xcc_id(); b.st = st;
    if (threadIdx.x == 0) (void)xb_add(&bar[XB_XCNT(b.x)], 1u);
    return b;
}
__device__ __forceinline__ void xcd_barrier_complete(unsigned* bar, unsigned x, unsigned& nloc, unsigned& nx) {
    const unsigned G = gridDim.x * gridDim.y * gridDim.z;
    unsigned sum, cnt, mine, sp = 0u;
    for (;;) {
        sum = 0u; cnt = 0u; mine = 0u;
#pragma unroll
        for (unsigned j = 0; j < 16; ++j) { const unsigned c = xb_ld(&bar[XB_XCNT(j)]); sum += c; cnt += (c > 0u) ? 1u : 0u; mine = (j == x) ? c : mine; }
        if (sum == G) break;
        __builtin_amdgcn_s_sleep(1);
        if ((++sp & 255u) == 0u) { if (xb_ld(&bar[XB_TMO])) break; if (sp > XB_SPIN_CAP) { atomicAdd(&bar[XB_TMO], 1u); break; } }
    }
    nloc = mine > 0u ? mine : 1u; nx = cnt > 0u ? cnt : 1u;
}

__device__ __forceinline__ void xcd_barrier(const XcdBarrier& b) {
    asm volatile("s_waitcnt vmcnt(0)" ::: "memory");
    __syncthreads();
    if (threadIdx.x == 0) {
        unsigned* bar = b.bar; asm volatile("" : "+s"(bar));
        __builtin_amdgcn_s_waitcnt(0);
        const unsigned bx = xb_xcc_id();
        unsigned nloc = b.st[0], nx = b.st[1];
        if (nloc == 0u) { xcd_barrier_complete(bar, bx, nloc, nx); b.st[0] = nloc; b.st[1] = nx; }
        const unsigned old = xb_add(&bar[XB_XSUB(bx)], 1u);
        const unsigned gen = old / nloc;
        if (old + 1u == (gen + 1u) * nloc) {
            __builtin_amdgcn_fence(__ATOMIC_RELEASE, "agent");
            asm volatile("s_waitcnt vmcnt(0)" ::: "memory");
            const unsigned og = xb_add(&bar[XB_TOP], 1u);
            const unsigned tg = og / nx;
            if (og + 1u == (tg + 1u) * nx) xb_add(&bar[XB_TOPGEN], 1u);
            else XB_SPIN(xb_ld(&bar[XB_TOPGEN]) == tg, bar);
            __builtin_amdgcn_fence(__ATOMIC_ACQUIRE, "agent");
            xb_add(&bar[XB_XGEN(bx)], 1u);
            asm volatile("s_waitcnt vmcnt(0)" ::: "memory");
        } else {
            XB_SPIN(xb_ld(&bar[XB_XGEN(bx)]) == gen, bar);
            __builtin_amdgcn_fence(__ATOMIC_ACQUIRE, "agent");
            asm volatile("s_waitcnt vmcnt(0)" ::: "memory");
        }
    }
    __syncthreads();
}

struct Args { const float* in[31]; float* out; unsigned char* ws; int layer, ph, pad0, pad1; };
struct Ctx {
    LAS unsigned char* lds;
    float* X;
    unsigned char* ws;
    const __attribute__((address_space(4))) unsigned char* ka;
    int G, bid, wave;
};
#define PHASE_BASES() GAS unsigned char* ws_g_ = (GAS unsigned char*)C.ws; const __attribute__((address_space(4))) unsigned char* ka_ = C.ka; asm volatile("" : "+s"(ws_g_), "+s"(ka_)); unsigned char* ws = (unsigned char*)ws_g_; \
    int lane_; asm volatile("v_mbcnt_lo_u32_b32 %0, -1, 0\n\tv_mbcnt_hi_u32_b32 %0, -1, %0" : "=v"(lane_)); int wave_ = C.wave; asm volatile("" : "+s"(wave_)); const int P_lane = lane_, P_wave = wave_, P_tid = P_wave * 64 + P_lane; (void)P_tid; (void)P_lane; (void)P_wave; \
    int P_bid = C.bid, P_G = C.G; asm volatile("" : "+s"(P_bid), "+s"(P_G)); (void)P_bid; (void)P_G
typedef const GAS float* cfptr_t;
#define INP(i) ((const float*)(((const __attribute__((address_space(4))) cfptr_t*)ka_)[i]))

__device__ __forceinline__ void ph_init(const Ctx& C) {
    PHASE_BASES();
    {
        const size_t gt = (size_t)P_bid * (NWAVES * 64) + P_tid, GT = (size_t)P_G * (NWAVES * 64);
        v4u* wl = (v4u*)(ws + WS_WLORA); const size_t n1 = (size_t)1536 * 384 * 2 / 16;
        for (size_t i = gt; i < n1; i += GT) { const int row = (int)(i / 48), pc = (int)(i % 48);
            const bool written = row < 512 ? (pc < 8) : row < 1024 ? (pc >= 8 && pc < 16) : (pc >= 16 && pc < 36);
            if (!written) wl[i] = (v4u){0u, 0u, 0u, 0u}; }
        v4u* wk = (v4u*)(ws + WS_WKV); const size_t n3 = (size_t)1024 * 256 * 2 / 16;
        for (size_t i = gt; i < n3; i += GT) if ((i & 31) >= 16) wk[i] = (v4u){0u, 0u, 0u, 0u};
        v4u* wp = (v4u*)(ws + WS_WIN + (size_t)NIN * DM * 2); const size_t n2 = (size_t)(NINP - NIN) * DM * 2 / 16;
        for (size_t i = gt; i < n2; i += GT) wp[i] = (v4u){0u, 0u, 0u, 0u};
    }
    const float* xin = INP(0); bf16* XB = (bf16*)(ws + WS_XB); float* rss = (float*)(ws + WS_RSS);
    const int gw = P_bid * NWAVES + P_wave, NGW = P_G * NWAVES;
    for (int row = gw; row < MTOK; row += 2 * NGW) {
        const int row1 = row + NGW;
        const f32x4* xr0 = (const f32x4*)(xin + (size_t)row * DM) + P_lane; const f32x4* xr1 = (const f32x4*)(xin + (size_t)row1 * DM) + P_lane;
        v2u* xb0 = (v2u*)(XB + (size_t)row * DM) + P_lane; v2u* xb1 = (v2u*)(XB + (size_t)row1 * DM) + P_lane;
        f32x4 v0[4], v1[4];
#pragma unroll
        for (int j = 0; j < 4; ++j) { v0[j] = xr0[64 * j]; v1[j] = xr1[64 * j]; }
        float s0 = 0.f, s1 = 0.f;
#pragma unroll
        for (int j = 0; j < 4; ++j) { v2u w; w.x = pk2(v0[j][0], v0[j][1]); w.y = pk2(v0[j][2], v0[j][3]); xb0[64 * j] = w; s0 += (v0[j][0] * v0[j][0] + v0[j][1] * v0[j][1]) + (v0[j][2] * v0[j][2] + v0[j][3] * v0[j][3]);
            v2u u; u.x = pk2(v1[j][0], v1[j][1]); u.y = pk2(v1[j][2], v1[j][3]); xb1[64 * j] = u; s1 += (v1[j][0] * v1[j][0] + v1[j][1] * v1[j][1]) + (v1[j][2] * v1[j][2] + v1[j][3] * v1[j][3]); }
        s0 = wave_sum(s0); s1 = wave_sum(s1);
        if (P_lane < 16) { rss[(size_t)row * 16 + P_lane] = (P_lane == 0) ? s0 : 0.f; rss[(size_t)row1 * 16 + P_lane] = (P_lane == 0) ? s1 : 0.f; }
    }
}

__device__ __forceinline__ void cvt_item(const float* W, int N, const float* gain, bf16* dst, int dstK, int koff, int guw, int rowoff, int item, int lane, LAS float* scr) {
    const int nblk = N / 32, kb = item / nblk, nb = item % nblk, k0 = 32 * kb, n0 = 32 * nb;
    float wv[16], gv[16];
#pragma unroll
    for (int i = 0; i < 16; ++i) { const int kk = 2 * i + (lane >> 5); wv[i] = W[(size_t)(k0 + kk) * N + n0 + (lane & 31)]; gv[i] = gain ? gain[k0 + kk] : 1.0f; }
#pragma unroll
    for (int i = 0; i < 16; ++i) { const int kk = 2 * i + (lane >> 5); scr[kk * 33 + (lane & 31)] = wv[i] * gv[i]; }
    LDS_WAIT(); asm volatile("" ::: "memory");
    const int rbase = (guw >= 0) ? ((n0 >> 7) * 256 + guw * 128 + (n0 & 127)) : (rowoff + n0);
    const int c = lane & 3;
#pragma unroll
    for (int j = 0; j < 2; ++j) { const int n = (lane >> 2) + 16 * j; const LAS float* s = scr + (8 * c) * 33 + n;
        v4u o; o.x = pk2(s[0 * 33], s[1 * 33]); o.y = pk2(s[2 * 33], s[3 * 33]); o.z = pk2(s[4 * 33], s[5 * 33]); o.w = pk2(s[6 * 33], s[7 * 33]);
        *(v4u*)(dst + (size_t)(rbase + n) * dstK + koff + k0 + 8 * c) = o; }
    LDS_WAIT(); asm volatile("" ::: "memory");
}
constexpr int I_FF = (DM / 32) * (DFF / 32);
constexpr int I_IN = (DM / 32) * (NIN / 32), I_OUT = (DM / 32) * (DM / 32), I_Q = (256 / 32) * (768 / 32), I_KV = (128 / 32) * (1024 / 32);
constexpr int I_W2 = (64 / 32) * (512 / 32), I_G2 = (160 / 32) * (512 / 32);
constexpr int CVT_NE = 3 * I_FF + I_IN + I_Q + I_KV + 2 * I_W2 + I_G2;
constexpr int CVT_NL = I_OUT + 3 * I_FF;
#define CVT_ITEM_BODY(late, l, r_in) do { \
        int r = (r_in); const float* W; int N; const float* gain = nullptr; bf16* dst; int dstK, koff = 0, guw = -1, rowoff = 0; \
        const size_t offGU = (size_t)(l) * DM * DFF, offIN = (size_t)(l) * DM * NIN; \
        if (!(late)) { \
            if (r < I_FF)                { W = INP(2) + offGU;  N = DFF; gain = INP(1) + (l) * DM;  dst = (bf16*)(ws + WS_WGU1); dstK = DM; guw = 0; } \
            else if ((r -= I_FF) < I_FF) { W = INP(3) + offGU;  N = DFF; gain = INP(1) + (l) * DM;  dst = (bf16*)(ws + WS_WGU1); dstK = DM; guw = 1; } \
            else if ((r -= I_FF) < I_FF) { W = INP(4) + offGU;  N = DM;  dst = (bf16*)(ws + WS_WDN1); dstK = DFF; } \
            else if ((r -= I_FF) < I_IN) { W = INP(6) + offIN;  N = NIN; gain = INP(5) + (l) * DM;  dst = (bf16*)(ws + WS_WIN); dstK = DM; } \
            else if ((r -= I_IN) < I_Q)  { W = INP(8) + (size_t)(l) * 256 * 768;   N = 768;  dst = (bf16*)(ws + WS_WQ);  dstK = 256; } \
            else if ((r -= I_Q) < I_KV)  { W = INP(10) + (size_t)(l) * 128 * 1024; N = 1024; dst = (bf16*)(ws + WS_WKV); dstK = 256; } \
            else if ((r -= I_KV) < I_W2) { W = INP(15) + (size_t)(l) * 64 * 512;   N = 512;  dst = (bf16*)(ws + WS_WLORA); dstK = 384; } \
            else if ((r -= I_W2) < I_W2) { W = INP(17) + (size_t)(l) * 64 * 512;   N = 512;  dst = (bf16*)(ws + WS_WLORA); dstK = 384; koff = 64;  rowoff = 512; } \
            else { r -= I_W2;              W = INP(18) + (size_t)(l) * 160 * 512;  N = 512;  dst = (bf16*)(ws + WS_WLORA); dstK = 384; koff = 128; rowoff = 1024; } \
        } else { \
            if (r < I_OUT / 2)                     { W = INP(26) + (size_t)(l) * DM * DM; N = DM; gain = INP(24) + (l) * 512; dst = (bf16*)(ws + WS_WOUT); dstK = DM; } \
            else if ((r -= I_OUT / 2) < I_OUT / 2) { W = INP(26) + (size_t)(l) * DM * DM + (size_t)512 * DM; N = DM; gain = INP(25) + (l) * 512; dst = (bf16*)(ws + WS_WOUT); dstK = DM; koff = 512; } \
            else if ((r -= I_OUT / 2) < I_FF)      { W = INP(28) + offGU; N = DFF; gain = INP(27) + (l) * DM; dst = (bf16*)(ws + WS_WGU2); dstK = DM; guw = 0; } \
            else if ((r -= I_FF) < I_FF)           { W = INP(29) + offGU; N = DFF; gain = INP(27) + (l) * DM; dst = (bf16*)(ws + WS_WGU2); dstK = DM; guw = 1; } \
            else { r -= I_FF;                        W = INP(30) + offGU; N = DM;  dst = (bf16*)(ws + WS_WDN2); dstK = DFF; } \
        } \
        cvt_item(W, N, gain, dst, dstK, koff, guw, rowoff, r, P_lane, scr); } while (0)
__device__ __forceinline__ void ph_cvt_early0(const Ctx& C) {
    PHASE_BASES();
    LAS float* scr = (LAS float*)(C.lds + P_wave * 8192);
    const int gw = P_bid * NWAVES + P_wave, NGW = P_G * NWAVES;
    for (int it = gw; it < CVT_NE; it += NGW) CVT_ITEM_BODY(false, 0, it);
}
constexpr int CVT_CH = 32;
__device__ __forceinline__ void cvt_chunk(const Ctx& C, bool late, int l, int chunk) {
    PHASE_BASES();
    LAS float* scr = (LAS float*)(C.lds + P_wave * 8192);
    const int ntot = late ? CVT_NL : CVT_NE;
#pragma unroll 1
    for (int i = 0; i < CVT_CH / 8; ++i) { const int it = chunk * CVT_CH + i * 8 + P_wave; if (it >= ntot) break;
        if (late) CVT_ITEM_BODY(true, l, it); else CVT_ITEM_BODY(false, l, it); }
}
constexpr int CVT_NCH_L = (CVT_NL + CVT_CH - 1) / CVT_CH, CVT_NCH_E = (CVT_NE + CVT_CH - 1) / CVT_CH;
constexpr int CVT_NCH_E01 = 3 * I_FF / CVT_CH;
__device__ __forceinline__ int cvt_take(const Ctx& C, int set, int l, int max_chunks, int soft_limit) {
    if (l >= NLAYER) return 0;
    PHASE_BASES();
    unsigned* ctr = (unsigned*)(ws + WS_CTL) + 2048 + 64 * (3 * l + set);
    volatile LAS unsigned* slot = (volatile LAS unsigned*)(C.lds + MISC_OFF) + 17;
    const int total = set == 1 ? CVT_NCH_L : set == 0 ? CVT_NCH_E01 : CVT_NCH_E - CVT_NCH_E01;
    int n = 0;
    for (; n < max_chunks; ++n) {
        __syncthreads();
        if (P_tid == 0) { unsigned v = __hip_atomic_load(ctr, __ATOMIC_RELAXED, __HIP_MEMORY_SCOPE_AGENT);
            v = ((int)v < soft_limit) ? __hip_atomic_fetch_add(ctr, 1u, __ATOMIC_RELAXED, __HIP_MEMORY_SCOPE_AGENT) : 0x7fffffffu; *slot = v; }
        __syncthreads();
        const int idx = __builtin_amdgcn_readfirstlane((int)*slot);
        if (idx >= total) break;
        cvt_chunk(C, set == 1, l, set == 2 ? idx + CVT_NCH_E01 : idx);
    }
    return n;
}
__device__ __forceinline__ void cvt_drain_early(const Ctx& C, int l) {
    if (l >= NLAYER) return;
    PHASE_BASES();
    unsigned* c0 = (unsigned*)(ws + WS_CTL) + 2048 + 64 * (3 * l);
    volatile LAS unsigned* slot = (volatile LAS unsigned*)(C.lds + MISC_OFF) + 17;
    __syncthreads();
    if (P_tid == 0) { const unsigned v0 = __hip_atomic_load(c0, __ATOMIC_RELAXED, __HIP_MEMORY_SCOPE_AGENT), v2 = __hip_atomic_load(c0 + 128, __ATOMIC_RELAXED, __HIP_MEMORY_SCOPE_AGENT);
        *slot = ((int)v0 < CVT_NCH_E01 ? 1u : 0u) | ((int)v2 < CVT_NCH_E - CVT_NCH_E01 ? 2u : 0u); }
    __syncthreads();
    const unsigned m = (unsigned)__builtin_amdgcn_readfirstlane((int)*slot);
    if (m & 1u) cvt_take(C, 0, l, 1 << 20, CVT_NCH_E);
    if (m & 2u) cvt_take(C, 2, l, 1 << 20, CVT_NCH_E);
}
__device__ __forceinline__ void cvt_drain_mix(const Ctx& C, int l) {
    PHASE_BASES();
    unsigned* cl = (unsigned*)(ws + WS_CTL) + 2048 + 64 * (3 * l + 1);
    unsigned* ce = (unsigned*)(ws + WS_CTL) + 2048 + 64 * (3 * (l + 1));
    volatile LAS unsigned* slot = (volatile LAS unsigned*)(C.lds + MISC_OFF) + 17;
    __syncthreads();
    if (P_tid == 0) { const unsigned v1 = __hip_atomic_load(cl, __ATOMIC_RELAXED, __HIP_MEMORY_SCOPE_AGENT), v0 = __hip_atomic_load(ce, __ATOMIC_RELAXED, __HIP_MEMORY_SCOPE_AGENT);
        *slot = ((int)v1 < CVT_NCH_L ? 1u : 0u) | ((int)v0 < CVT_NCH_E01 - 128 ? 2u : 0u); }
    __syncthreads();
    const unsigned m = (unsigned)__builtin_amdgcn_readfirstlane((int)*slot);
    if (m & 1u) cvt_take(C, 1, l, 1 << 20, CVT_NCH_L);
    if (m & 2u) cvt_take(C, 0, l + 1, 1 << 20, CVT_NCH_E01 - 128);
}
__device__ __forceinline__ void ps8(const bf16* pr, bool hasprev, const float* mu, int c0, float (&o)[8]) {
    const v4u a = *(const v4u*)(pr + RW_OFF + c0);
    v4u b = (v4u){0u, 0u, 0u, 0u}; if (hasprev) b = *(const v4u*)(pr - NINP + RW_OFF + c0);
    const f32x4 m0 = *(const f32x4*)(mu + c0), m1 = *(const f32x4*)(mu + c0 + 4);
#pragma unroll
    for (int i = 0; i < 4; ++i) { const float x0 = bflo(a[i]), x1 = bfhi(a[i]), y0 = bflo(b[i]), y1 = bfhi(b[i]);
        const float mm0 = (i < 2) ? m0[2 * i] : m1[2 * i - 4], mm1 = (i < 2) ? m0[2 * i + 1] : m1[2 * i - 3];
        o[2 * i] = x0 + mm0 * (y0 - x0); o[2 * i + 1] = x1 + mm1 * (y1 - x1); }
}
__device__ __forceinline__ v4u pack8(const float (&o)[8]) { v4u w; w.x = pk2(o[0], o[1]); w.y = pk2(o[2], o[3]); w.z = pk2(o[4], o[5]); w.w = pk2(o[6], o[7]); return w; }
__device__ __forceinline__ void ph_prep_a(const Ctx& C, int l) {
    PHASE_BASES(); const int lane = P_lane;
    const bf16* P = (const bf16*)(ws + WS_P);
    bf16* QLN = (bf16*)(ws + WS_QLN); bf16* KVLN = (bf16*)(ws + WS_KVLN); bf16* LA = (bf16*)(ws + WS_LA); bf16* KPE = (bf16*)(ws + WS_KPE);
    const float* gq = INP(7) + l * 256; const float* gkv = INP(9) + l * 128; const float* mu = INP(13) + l * 1824;
    const int gw = P_bid * NWAVES + P_wave, NGW = P_G * NWAVES;
    for (int row = gw; row < MTOK; row += NGW) {
        const bf16* pr = P + (size_t)row * NINP; const bool hasprev = (row & (SEQ - 1)) != 0;
        {
            const v2u raw = *(const v2u*)(pr + 4 * lane);
            const float v0 = bflo(raw.x), v1 = bfhi(raw.x), v2 = bflo(raw.y), v3 = bfhi(raw.y);
            const float ss = wave_sum((v0 * v0 + v1 * v1) + (v2 * v2 + v3 * v3));
            const float rs = rsqrtf(ss * (1.0f / 256.0f) + EPS);
            const f32x4 g = *(const f32x4*)(gq + 4 * lane);
            v2u w; w.x = pk2(v0 * rs * g[0], v1 * rs * g[1]); w.y = pk2(v2 * rs * g[2], v3 * rs * g[3]);
            *(v2u*)(QLN + (size_t)row * 256 + 4 * lane) = w;
        }
        {
            const unsigned raw = *(const unsigned*)(pr + 256 + 2 * lane);
            const float v0 = bflo(raw), v1 = bfhi(raw);
            const float ss = wave_sum(v0 * v0 + v1 * v1);
            const float rs = rsqrtf(ss * (1.0f / 128.0f) + EPS);
            *(unsigned*)(KVLN + (size_t)row * 256 + 2 * lane) = pk2(v0 * rs * gkv[2 * lane], v1 * rs * gkv[2 * lane + 1]);
            *(unsigned*)(KVLN + (size_t)row * 256 + 128 + 2 * lane) = 0u;
        }
        if (lane < 16) *(unsigned*)(KPE + (size_t)row * 32 + 2 * lane) = *(const unsigned*)(pr + 384 + 2 * lane);
        if (lane < 48) {
            float o[8];
            if (lane < 8) { ps8(pr, hasprev, mu, 512 + 8 * lane, o);
#pragma unroll
                for (int e = 0; e < 8; ++e) o[e] = tanhf(o[e]); }
            else if (lane < 16) { ps8(pr, hasprev, mu, 1600 + 8 * (lane - 8), o); }
            else if (lane < 36) { ps8(pr, hasprev, mu, 1664 + 8 * (lane - 16), o);
#pragma unroll
                for (int e = 0; e < 8; ++e) o[e] = 1.0f / (1.0f + __expf(-o[e])); }
            else {
#pragma unroll
                for (int e = 0; e < 8; ++e) o[e] = 0.f; }
            *(v4u*)(LA + (size_t)row * 384 + 8 * lane) = pack8(o);
        }
    }
}

__device__ __forceinline__ void unpk8(const v4u w, float (&o)[8]) {
#pragma unroll
    for (int i = 0; i < 4; ++i) { o[2 * i] = bflo(w[i]); o[2 * i + 1] = bfhi(w[i]); }
}
__device__ __forceinline__ float grp8_sum(float v) { return pg8::oct_sum(v); }
__device__ __forceinline__ void ph_prep_c(const Ctx& C, int l) {
    PHASE_BASES(); const int lane = P_lane;
    const bf16* QRAW = (const bf16*)(ws + WS_QRAW); const bf16* KVRAW = (const bf16*)(ws + WS_KVRAW); const bf16* KPE = (const bf16*)(ws + WS_KPE);
    bf16* Q = (bf16*)(ws + WS_Q); bf16* K = (bf16*)(ws + WS_K); bf16* V = (bf16*)(ws + WS_V);
    const float* rope = (const float*)(ws + WS_ROPE);
    const float* qn = INP(11) + l * 96; const float* kn = INP(12) + l * 96;
    const int h = lane >> 3, sub = lane & 7; const bool pe = sub < 4;
    const bf16* P = (const bf16*)(ws + WS_P); const bf16* AS = (const bf16*)(ws + WS_AS); float* KN = (float*)(ws + WS_KN); float* BS = (float*)(ws + WS_BS);
    const float* mu = INP(13) + l * 1824; const float* k_k = INP(19) + l * 512; const float* k_a = INP(20) + l * 512; const float* r_k = INP(21) + l * 512;
    float kkc[8], kac[8], rkc[8];
#pragma unroll
    for (int e = 0; e < 8; ++e) { kkc[e] = k_k[8 * lane + e]; kac[e] = k_a[8 * lane + e]; rkc[e] = r_k[8 * lane + e]; }
    float gq0[8], gk0[8], gq1[8], gk1[8];
#pragma unroll
    for (int e = 0; e < 8; ++e) { gq0[e] = qn[8 * sub + e]; gk0[e] = kn[8 * sub + e]; gq1[e] = pe ? qn[64 + 8 * sub + e] : 0.f; gk1[e] = pe ? kn[64 + 8 * sub + e] : 0.f; }
    const float QSCALE = 0.10206207261596575f * 1.4426950408889634f;
    const int gw = P_bid * NWAVES + P_wave, NGW = P_G * NWAVES;
    for (int row = gw; row < MTOK; row += NGW) {
        const int b = row >> 12, s = row & (SEQ - 1);
        const size_t ho = ((size_t)(b * NHEAD + h) * SEQ + s);
        float cs[8], sn[8];
        {   const float* rp = rope + s * 32 + 8 * (sub & 1); const f32x4 c0 = *(const f32x4*)rp, c1 = *(const f32x4*)(rp + 4), s0 = *(const f32x4*)(rp + 16), s1 = *(const f32x4*)(rp + 20);
#pragma unroll
            for (int e = 0; e < 4; ++e) { cs[e] = c0[e]; cs[4 + e] = c1[e]; sn[e] = s0[e]; sn[4 + e] = s1[e]; } }
        {
            float x0[8], x1[8];
            unpk8(*(const v4u*)(QRAW + (size_t)row * 768 + h * 96 + 8 * sub), x0);
            if (pe) unpk8(*(const v4u*)(QRAW + (size_t)row * 768 + h * 96 + 64 + 8 * sub), x1); else {
#pragma unroll
                for (int e = 0; e < 8; ++e) x1[e] = 0.f; }
            float ss = 0.f;
#pragma unroll
            for (int e = 0; e < 8; ++e) ss += x0[e] * x0[e] + x1[e] * x1[e];
            const float rs = rsqrtf(grp8_sum(ss) * (1.0f / 96.0f) + EPS) * QSCALE;
            float y0[8], y1[8];
#pragma unroll
            for (int e = 0; e < 8; ++e) { y0[e] = x0[e] * rs * gq0[e]; const float t = x1[e] * rs * gq1[e]; const float pt = pg8::swz_xor<2>(t);
                y1[e] = (sub < 2) ? (t * cs[e] - pt * sn[e]) : (t * cs[e] + pt * sn[e]); }
            *(v4u*)(Q + ho * 96 + 8 * sub) = pack8(y0); if (pe) *(v4u*)(Q + ho * 96 + 64 + 8 * sub) = pack8(y1);
        }
        {
            float x0[8], x1[8];
            unpk8(*(const v4u*)(KVRAW + (size_t)row * 1024 + h * 128 + 8 * sub), x0);
            if (pe) unpk8(*(const v4u*)(KPE + (size_t)row * 32 + 8 * sub), x1); else {
#pragma unroll
                for (int e = 0; e < 8; ++e) x1[e] = 0.f; }
            float ss = 0.f;
#pragma unroll
            for (int e = 0; e < 8; ++e) ss += x0[e] * x0[e] + x1[e] * x1[e];
            const float rs = rsqrtf(grp8_sum(ss) * (1.0f / 96.0f) + EPS);
            float y0[8], y1[8];
#pragma unroll
            for (int e = 0; e < 8; ++e) { y0[e] = x0[e] * rs * gk0[e]; const float t = x1[e] * rs * gk1[e]; const float pt = pg8::swz_xor<2>(t);
                y1[e] = (sub < 2) ? (t * cs[e] - pt * sn[e]) : (t * cs[e] + pt * sn[e]); }
            *(v4u*)(K + ho * 96 + 8 * sub) = pack8(y0); if (pe) *(v4u*)(K + ho * 96 + 64 + 8 * sub) = pack8(y1);
            *(v4u*)(V + ho * 64 + 8 * sub) = *(const v4u*)(KVRAW + (size_t)row * 1024 + h * 128 + 64 + 8 * sub);
        }
        {
            const bf16* pr = P + (size_t)row * NINP; const bool hasprev = s != 0;
            float r[8], k[8], a[8];
            ps8(pr, hasprev, mu, 8 * lane, r); ps8(pr, hasprev, mu, 576 + 8 * lane, k);
            unpk8(*(const v4u*)(AS + (size_t)row * 512 + 8 * lane), a);
            float n2 = 0.f, bs = 0.f;
#pragma unroll
            for (int e = 0; e < 8; ++e) { const float kk = k[e] * kkc[e]; n2 += kk * kk; bs += r[e] * (k[e] * (1.0f + (a[e] - 1.0f) * kac[e])) * rkc[e]; }
            n2 = grp8_sum(n2); bs = grp8_sum(bs);
            if (sub == 0) { KN[(size_t)row * 8 + h] = 1.0f / fmaxf(sqrtf(n2), 1e-12f); BS[(size_t)row * 8 + h] = bs; }
        }
    }
}

constexpr int KROW = 208;
constexpr int VROW = 136;
constexpr int KT_BYTES = 64 * KROW, VT_BYTES = 64 * VROW, ATT_BUF = KT_BYTES + VT_BYTES;
__device__ __forceinline__ void att_unit(const Ctx& C, int u) {
    PHASE_BASES(); const int lane = P_lane, wid = P_wave, tid = P_tid;
    const bf16* Q = (const bf16*)(ws + WS_Q); const bf16* K = (const bf16*)(ws + WS_K); const bf16* V = (const bf16*)(ws + WS_V);
    bf16* YN = (bf16*)(ws + WS_YN); float* SSA = (float*)(ws + WS_SSA);
    const int r32 = lane & 31, hi = lane >> 5;
    {
        const int bh = u & 31, qb = 15 - (u >> 5);
        const int q0 = qb * 256, NT = (q0 + 256) / 64, q0w = q0 + 32 * wid, mylast = q0w >> 6;
        const bf16* Kh = K + (size_t)bh * SEQ * 96; const bf16* Vh = V + (size_t)bh * SEQ * 64;
        bf16x8 qf[6];
#pragma unroll
        for (int ks = 0; ks < 6; ++ks) qf[ks] = *(const bf16x8*)(Q + ((size_t)bh * SEQ + q0w + r32) * 96 + ks * 16 + hi * 8);
        f32x16 o0, o1;
#pragma unroll
        for (int i = 0; i < 16; ++i) { o0[i] = 0.f; o1[i] = 0.f; }
        float mref = 0.f, lrun = 0.f; bool first = true; f32x16 negm;
#pragma unroll
        for (int i = 0; i < 16; ++i) negm[i] = 0.f;
        v4u ka0, ka1 = (v4u){0u, 0u, 0u, 0u}, va, kb0, kb1 = (v4u){0u, 0u, 0u, 0u}, vb_;
#define ATT_LOAD(K0, K1, V_, tt) do { const v4u* kt = (const v4u*)(Kh + (size_t)(tt) * 64 * 96); const v4u* vt = (const v4u*)(Vh + (size_t)(tt) * 64 * 64); K0 = kt[tid]; if (tid < 256) K1 = kt[512 + tid]; V_ = vt[tid]; } while (0)
#define ATT_STORE(K0, K1, V_, bufoff) do { \
            { const int c = tid, rr = c / 12, cc = c % 12; *(LAS v4u*)(C.lds + (bufoff) + rr * KROW + cc * 16) = K0; } \
            if (tid < 256) { const int c = 512 + tid, rr = c / 12, cc = c % 12; *(LAS v4u*)(C.lds + (bufoff) + rr * KROW + cc * 16) = K1; } \
            { const int kv = tid >> 3, d0 = (tid & 7) * 8; LAS unsigned short* vbp = (LAS unsigned short*)(C.lds + (bufoff) + KT_BYTES) + kv; \
              _Pragma("unroll") for (int e = 0; e < 4; ++e) { vbp[(d0 + 2 * e) * (VROW / 2)] = (unsigned short)(V_[e] & 0xffffu); vbp[(d0 + 2 * e + 1) * (VROW / 2)] = (unsigned short)(V_[e] >> 16); } } \
        } while (0)
#define ATT_COMPUTE(T_, BUF_) do { \
            if ((T_) <= mylast) { \
                const LAS unsigned char* kb = C.lds + (BUF_); const LAS unsigned char* vb = C.lds + (BUF_) + KT_BYTES; \
                bf16x8 kf0[6], kf1[6]; \
_Pragma("unroll") \
                for (int ks = 0; ks < 6; ++ks) { kf0[ks] = *(const LAS bf16x8*)(kb + r32 * KROW + (ks * 16 + hi * 8) * 2); kf1[ks] = *(const LAS bf16x8*)(kb + (32 + r32) * KROW + (ks * 16 + hi * 8) * 2); } \
                s16x4 vlo[2][2][2], vhi[2][2][2]; \
_Pragma("unroll") \
                for (int hh = 0; hh < 2; ++hh) \
_Pragma("unroll") \
                    for (int s = 0; s < 2; ++s) \
_Pragma("unroll") \
                        for (int db = 0; db < 2; ++db) { const LAS unsigned char* vp = vb + (32 * db + r32) * VROW + (32 * hh + 16 * s + 4 * hi) * 2; \
                            vlo[hh][s][db] = *(const LAS s16x4*)(vp); vhi[hh][s][db] = *(const LAS s16x4*)(vp + 16); } \
                f32x16 p0 = __builtin_amdgcn_mfma_f32_32x32x16_bf16(kf0[0], qf[0], negm, 0, 0, 0); \
                f32x16 p1 = __builtin_amdgcn_mfma_f32_32x32x16_bf16(kf1[0], qf[0], negm, 0, 0, 0); \
_Pragma("unroll") \
                for (int ks = 1; ks < 6; ++ks) { \
                    p0 = __builtin_amdgcn_mfma_f32_32x32x16_bf16(kf0[ks], qf[ks], p0, 0, 0, 0); \
                    p1 = __builtin_amdgcn_mfma_f32_32x32x16_bf16(kf1[ks], qf[ks], p1, 0, 0, 0); \
                } \
                float mt = p0[0]; \
_Pragma("unroll") \
                for (int i = 1; i < 16; ++i) mt = fmaxf(mt, p0[i]); \
_Pragma("unroll") \
                for (int i = 0; i < 16; ++i) mt = fmaxf(mt, p1[i]); \
                mt = pg8::max_x32(mt); \
                if (__builtin_amdgcn_ballot_w64(first || mt > 8.0f) != 0ull) { \
                    const float dl = first ? mt : fmaxf(mt, 0.f); \
                    const float alpha = first ? 0.f : __builtin_amdgcn_exp2f(-dl); \
                    mref += dl; lrun *= alpha; \
_Pragma("unroll") \
                    for (int i = 0; i < 16; ++i) { p0[i] -= dl; p1[i] -= dl; o0[i] *= alpha; o1[i] *= alpha; negm[i] = -mref; } \
                    first = false; \
                } \
                float ls = 0.f; \
_Pragma("unroll") \
                for (int i = 0; i < 16; ++i) { p0[i] = __builtin_amdgcn_exp2f(p0[i]); p1[i] = __builtin_amdgcn_exp2f(p1[i]); ls += p0[i] + p1[i]; } \
                lrun += ls; \
_Pragma("unroll") \
                for (int hh = 0; hh < 2; ++hh) \
_Pragma("unroll") \
                    for (int s = 0; s < 2; ++s) { \
                        v4u pw; \
_Pragma("unroll") \
                        for (int e = 0; e < 4; ++e) { const float x0 = hh ? p1[8 * s + 2 * e] : p0[8 * s + 2 * e], x1 = hh ? p1[8 * s + 2 * e + 1] : p0[8 * s + 2 * e + 1]; \
                            pw[e] = pk2(x0, x1); } \
                        const bf16x8 pf = __builtin_bit_cast(bf16x8, pw); \
_Pragma("unroll") \
                        for (int db = 0; db < 2; ++db) { \
                            const s16x4 lo = vlo[hh][s][db], hi4 = vhi[hh][s][db]; \
                            const bf16x8 vf = (bf16x8){lo[0], lo[1], lo[2], lo[3], hi4[0], hi4[1], hi4[2], hi4[3]}; \
                            if (db == 0) o0 = __builtin_amdgcn_mfma_f32_32x32x16_bf16(vf, pf, o0, 0, 0, 0); \
                            else         o1 = __builtin_amdgcn_mfma_f32_32x32x16_bf16(vf, pf, o1, 0, 0, 0); \
                        } \
                    } \
            } \
        } while (0)
        __syncthreads();
        ATT_LOAD(ka0, ka1, va, 0); ATT_LOAD(kb0, kb1, vb_, 1);
        ATT_STORE(ka0, ka1, va, 0);
        __syncthreads();
        for (int t = 0; t < NT; t += 2) {
            if (t + 2 < NT) ATT_LOAD(ka0, ka1, va, t + 2);
            ATT_COMPUTE(t, 0);
            ATT_STORE(kb0, kb1, vb_, ATT_BUF);
            __syncthreads();
            if (t + 3 < NT) ATT_LOAD(kb0, kb1, vb_, t + 3);
            ATT_COMPUTE(t + 1, ATT_BUF);
            if (t + 2 < NT) ATT_STORE(ka0, ka1, va, 0);
            __syncthreads();
        }
#undef ATT_COMPUTE
#undef ATT_LOAD
#undef ATT_STORE
        const float lt = pg8::sum_x32(lrun); const float inv = 1.0f / lt;
        const int b = bh >> 3, h = bh & 7; const size_t token = (size_t)b * SEQ + q0w + r32;
        bf16* yp = YN + token * 1024 + h * 64; float ssq = 0.f;
#pragma unroll
        for (int g = 0; g < 4; ++g) {
            const float a0 = o0[4 * g] * inv, a1 = o0[4 * g + 1] * inv, a2 = o0[4 * g + 2] * inv, a3 = o0[4 * g + 3] * inv;
            const float c0 = o1[4 * g] * inv, c1 = o1[4 * g + 1] * inv, c2 = o1[4 * g + 2] * inv, c3 = o1[4 * g + 3] * inv;
            ssq += ((a0 * a0 + a1 * a1) + (a2 * a2 + a3 * a3)) + ((c0 * c0 + c1 * c1) + (c2 * c2 + c3 * c3));
            v2u w0; w0.x = pk2(a0, a1); w0.y = pk2(a2, a3); *(v2u*)(yp + 8 * g + 4 * hi) = w0;
            v2u w1; w1.x = pk2(c0, c1); w1.y = pk2(c2, c3); *(v2u*)(yp + 32 + 8 * g + 4 * hi) = w1;
        }
        ssq = pg8::sum_x32(ssq);
        if (hi == 0) SSA[token * 8 + h] = ssq;
    }
}


constexpr int SA_PITCH = 144, SA_BUF = 64 * SA_PITCH;
constexpr int SA_TOT = 14 * SA_BUF;
static_assert(SA_TOT + 2048 <= RING_BYTES, "scan LDS");
constexpr int SA_B14 = RING_BYTES + 4096;
static_assert(SA_B14 + SA_BUF <= LDS_BYTES, "scan LDS (15th buffer)");
typedef float f32x4s __attribute__((ext_vector_type(4)));
__device__ __forceinline__ void sa_mm(const LAS unsigned char* lds, int aoff, int btoff, f32x4s (&acc)[2], int r0, int c0, int l15, int q) {
#pragma unroll
    for (int ks = 0; ks < 2; ++ks) {
        const bf16x8 a = *(const LAS bf16x8*)(lds + aoff + (r0 + l15) * SA_PITCH + (32 * ks + 8 * q) * 2);
#pragma unroll
        for (int n = 0; n < 2; ++n) {
            const bf16x8 b = *(const LAS bf16x8*)(lds + btoff + (c0 + 16 * n + l15) * SA_PITCH + (32 * ks + 8 * q) * 2);
            acc[n] = __builtin_amdgcn_mfma_f32_16x16x32_bf16(a, b, acc[n], 0, 0, 0);
        }
    }
}
__device__ __forceinline__ void sa_mm_a2(const LAS unsigned char* lds, int aoff, int bt1, int bt2, f32x4s (&acc1)[2], f32x4s (&acc2)[2], int r0, int c0, int l15, int q) {
#pragma unroll
    for (int ks = 0; ks < 2; ++ks) {
        const bf16x8 a = *(const LAS bf16x8*)(lds + aoff + (r0 + l15) * SA_PITCH + (32 * ks + 8 * q) * 2);
#pragma unroll
        for (int n = 0; n < 2; ++n) {
            const bf16x8 b1 = *(const LAS bf16x8*)(lds + bt1 + (c0 + 16 * n + l15) * SA_PITCH + (32 * ks + 8 * q) * 2);
            const bf16x8 b2 = *(const LAS bf16x8*)(lds + bt2 + (c0 + 16 * n + l15) * SA_PITCH + (32 * ks + 8 * q) * 2);
            acc1[n] = __builtin_amdgcn_mfma_f32_16x16x32_bf16(a, b1, acc1[n], 0, 0, 0);
            acc2[n] = __builtin_amdgcn_mfma_f32_16x16x32_bf16(a, b2, acc2[n], 0, 0, 0);
        }
    }
}
__device__ __forceinline__ void sa_mm_b2(const LAS unsigned char* lds, int a1off, int a2off, int btoff, f32x4s (&acc1)[2], f32x4s (&acc2)[2], int r0, int c0, int l15, int q) {
#pragma unroll
    for (int ks = 0; ks < 2; ++ks) {
        const bf16x8 a1 = *(const LAS bf16x8*)(lds + a1off + (r0 + l15) * SA_PITCH + (32 * ks + 8 * q) * 2);
        const bf16x8 a2 = *(const LAS bf16x8*)(lds + a2off + (r0 + l15) * SA_PITCH + (32 * ks + 8 * q) * 2);
#pragma unroll
        for (int n = 0; n < 2; ++n) {
            const bf16x8 b = *(const LAS bf16x8*)(lds + btoff + (c0 + 16 * n + l15) * SA_PITCH + (32 * ks + 8 * q) * 2);
            acc1[n] = __builtin_amdgcn_mfma_f32_16x16x32_bf16(a1, b, acc1[n], 0, 0, 0);
            acc2[n] = __builtin_amdgcn_mfma_f32_16x16x32_bf16(a2, b, acc2[n], 0, 0, 0);
        }
    }
}
__device__ __forceinline__ void sa_zero(f32x4s (&acc)[2]) { acc[0] = (f32x4s){0.f, 0.f, 0.f, 0.f}; acc[1] = (f32x4s){0.f, 0.f, 0.f, 0.f}; }
__device__ __forceinline__ void sa_mask(f32x4s (&acc)[2], int r0, int c0, int l15, int q, bool incl, bool tr = false) {
#pragma unroll
    for (int n = 0; n < 2; ++n)
#pragma unroll
        for (int i = 0; i < 4; ++i) { const int row = r0 + 4 * q + i, col = c0 + 16 * n + l15; const int lo = tr ? row : col, hi = tr ? col : row; const bool keep = incl ? (lo <= hi) : (lo < hi); if (!keep) acc[n][i] = 0.f; }
}
__device__ __forceinline__ void sa_storeT(LAS unsigned char* lds, int off, const f32x4s (&acc)[2], int r0, int c0, int l15, int q, bool plus_eye) {
#pragma unroll
    for (int n = 0; n < 2; ++n) { const int col = c0 + 16 * n + l15, row = r0 + 4 * q; f32x4s v = acc[n];
        if (plus_eye) {
#pragma unroll
            for (int i = 0; i < 4; ++i) if (row + i == col) v[i] += 1.0f; }
        v2u w; w.x = pk2(v[0], v[1]); w.y = pk2(v[2], v[3]);
        *(LAS v2u*)(lds + off + col * SA_PITCH + row * 2) = w; }
}
__device__ __forceinline__ void sa_storeN(LAS unsigned char* lds, int off, const f32x4s (&acc)[2], int r0, int c0, int l15, int q) {
#pragma unroll
    for (int n = 0; n < 2; ++n)
#pragma unroll
        for (int i = 0; i < 4; ++i) ((LAS unsigned short*)(lds + off + (r0 + 4 * q + i) * SA_PITCH))[c0 + 16 * n + l15] = (unsigned short)f2bf(acc[n][i]);
}
__device__ __forceinline__ void sa_loadT(const LAS unsigned char* lds, int off, f32x4s (&acc)[2], int r0, int c0, int l15, int q) {
#pragma unroll
    for (int n = 0; n < 2; ++n) { const v2u w = *(const LAS v2u*)(lds + off + (c0 + 16 * n + l15) * SA_PITCH + (r0 + 4 * q) * 2);
        acc[n] = (f32x4s){bflo(w.x), bfhi(w.x), bflo(w.y), bfhi(w.y)}; }
}
#define SBUF(n) ((n) * SA_BUF)
#define SA_BAR() asm volatile("s_waitcnt lgkmcnt(0)\n\ts_barrier" ::: "memory")
__device__ __forceinline__ void ph_scan_a(const Ctx& C, int l) {
    PHASE_BASES(); const int lane = P_lane, w = P_wave;
    const bf16* P = (const bf16*)(ws + WS_P); const bf16* AS = (const bf16*)(ws + WS_AS); const float* LW = (const float*)(ws + WS_DEC); const float* KN = (const float*)(ws + WS_KN);
    const float* mu = INP(13) + l * 1824; const float* k_k = INP(19) + l * 512; const float* k_a = INP(20) + l * 512;
    bf16* Pg = (bf16*)(ws + WS_SP); bf16* QTg = (bf16*)(ws + WS_SQT); bf16* RHg = (bf16*)(ws + WS_SRH); bf16* YVTg = (bf16*)(ws + WS_SYVT);
    LAS unsigned char* lds = C.lds;
    LAS float* tot = (LAS float*)(lds + SA_TOT);
    const int r0 = 16 * (w >> 1), c0 = 32 * (w & 1), l15 = lane & 15, q = lane >> 4;
    unsigned short xr[9], xk[9], xv[9], xa[8]; float lw[8], xn[8];
#define SA_LOAD(u_) do { const int bh_ = (u_) >> 6, c_ = (u_) & 63, b_ = bh_ >> 3, h_ = bh_ & 7; const size_t tok_ = (size_t)b_ * SEQ + 64 * c_ + 8 * w; \
        const bf16* pp = P + tok_ * NINP + RW_OFF + 64 * h_ + lane; const bool hasprev = (64 * c_ + 8 * w) != 0; const size_t e_ = tok_ * 512 + 64 * h_ + lane; \
        xr[0] = hasprev ? pp[-NINP] : (unsigned short)0; xk[0] = hasprev ? pp[-NINP + 576] : (unsigned short)0; xv[0] = hasprev ? pp[-NINP + 1088] : (unsigned short)0; \
        _Pragma("unroll") for (int j = 0; j < 8; ++j) { xr[j + 1] = pp[(size_t)j * NINP]; xk[j + 1] = pp[(size_t)j * NINP + 576]; xv[j + 1] = pp[(size_t)j * NINP + 1088]; \
            lw[j] = LW[e_ + (size_t)j * 512]; xa[j] = AS[e_ + (size_t)j * 512]; xn[j] = KN[(tok_ + j) * 8 + h_]; } } while (0)
    const int ubase = ((P_bid >> 6) * 8) * 64 + (P_bid & 63);
    SA_LOAD(ubase);
    for (int hh = 0; hh < 8; ++hh) { const int unit = ubase + 64 * hh;
        const int bh = unit >> 6, h = bh & 7;
        const int ch = 64 * h + lane;
        const float mu_r = mu[ch], mu_k = mu[576 + ch], mu_v = mu[1088 + ch], kkc = k_k[ch], kac = k_a[ch];
        float cum[8];
        cum[0] = lw[0];
#pragma unroll
        for (int j = 1; j < 8; ++j) cum[j] = cum[j - 1] + lw[j];
        tot[w * 64 + lane] = cum[7];
        float lwv[8], rr[8], k2[8], kkn[8], kka[8], vsh[8];
#pragma unroll
        for (int j = 0; j < 8; ++j) {
            const float p1 = bf2f(xr[j + 1]), p0 = bf2f(xr[j]), q1 = bf2f(xk[j + 1]), q0 = bf2f(xk[j]), v1 = bf2f(xv[j + 1]), v0 = bf2f(xv[j]);
            const float r = p1 + mu_r * (p0 - p1), k = q1 + mu_k * (q0 - q1);
            const float a = bf2f(xa[j]);
            const float kn = k * kkc * xn[j];
            lwv[j] = lw[j]; rr[j] = r; k2[j] = k * (1.0f + (a - 1.0f) * kac); kkn[j] = kn; kka[j] = kn * a; vsh[j] = v1 + mu_v * (v0 - v1);
        }
        if (hh + 1 < 8) SA_LOAD(unit + 64);
        SA_BAR();
        float offs = 0.f, total = 0.f;
#pragma unroll
        for (int ww = 0; ww < 8; ++ww) { const float t = tot[ww * 64 + lane]; total += t; if (ww < w) offs += t; }
        unsigned short at[8], bt[8], kt[8], rt[8], bhh[8], khh[8], vv[8];
#pragma unroll
        for (int j = 0; j < 8; ++j) {
            const float cj = offs + cum[j];
            const float eprev = __expf(cj - lwv[j]), eneg = __expf(-cj), epos = __expf(cj), ehat = __expf(total - cj);
            vv[j] = (unsigned short)f2bf(vsh[j]);
            at[j] = (unsigned short)f2bf(-kkn[j] * eprev); bt[j] = (unsigned short)f2bf(kka[j] * eneg); kt[j] = (unsigned short)f2bf(k2[j] * eneg); rt[j] = (unsigned short)f2bf(rr[j] * epos);
            bhh[j] = (unsigned short)f2bf(kka[j] * ehat); khh[j] = (unsigned short)f2bf(k2[j] * ehat);
        }
#pragma unroll
        for (int j = 0; j < 8; ++j) { const int i = 8 * w + j;
            ((LAS unsigned short*)(lds + SBUF(0) + i * SA_PITCH))[lane] = at[j]; ((LAS unsigned short*)(lds + SBUF(1) + i * SA_PITCH))[lane] = bt[j];
            ((LAS unsigned short*)(lds + SBUF(2) + i * SA_PITCH))[lane] = kt[j]; ((LAS unsigned short*)(lds + SBUF(3) + i * SA_PITCH))[lane] = rt[j]; }
#define PK8(x) ((v4u){(unsigned)x[0] | ((unsigned)x[1] << 16), (unsigned)x[2] | ((unsigned)x[3] << 16), (unsigned)x[4] | ((unsigned)x[5] << 16), (unsigned)x[6] | ((unsigned)x[7] << 16)})
        *(LAS v4u*)(lds + SBUF(4) + lane * SA_PITCH + 16 * w) = PK8(at);  *(LAS v4u*)(lds + SBUF(5) + lane * SA_PITCH + 16 * w) = PK8(bhh);
        *(LAS v4u*)(lds + SBUF(6) + lane * SA_PITCH + 16 * w) = PK8(khh); *(LAS v4u*)(lds + SBUF(7) + lane * SA_PITCH + 16 * w) = PK8(vv);
#undef PK8
        SA_BAR();
        f32x4s acc[2];
        sa_zero(acc); sa_mm(lds, SBUF(0), SBUF(1), acc, r0, c0, l15, q); sa_mask(acc, r0, c0, l15, q, false);
        sa_storeN(lds, SBUF(8), acc, r0, c0, l15, q); sa_storeT(lds, SBUF(9), acc, r0, c0, l15, q, false); sa_storeT(lds, SBUF(10), acc, r0, c0, l15, q, true);
        f32x4s acc2[2];
        sa_zero(acc); sa_zero(acc2); sa_mm_a2(lds, SBUF(2), SBUF(0), SBUF(3), acc, acc2, r0, c0, l15, q);
        sa_mask(acc, r0, c0, l15, q, false, true); sa_mask(acc2, r0, c0, l15, q, true, true);
        sa_storeT(lds, SBUF(11), acc, r0, c0, l15, q, false); sa_storeT(lds, SBUF(12), acc2, r0, c0, l15, q, false);
        sa_zero(acc); sa_mm(lds, SBUF(1), SBUF(3), acc, r0, c0, l15, q); sa_mask(acc, r0, c0, l15, q, true, true);
        sa_storeT(lds, SA_B14, acc, r0, c0, l15, q, false);
        SA_BAR();
        sa_zero(acc); sa_mm(lds, SBUF(8), SBUF(9), acc, r0, c0, l15, q); sa_storeN(lds, SBUF(1), acc, r0, c0, l15, q); sa_storeT(lds, SBUF(2), acc, r0, c0, l15, q, false);
        SA_BAR();
        sa_loadT(lds, SBUF(10), acc, r0, c0, l15, q); sa_zero(acc2); sa_mm_a2(lds, SBUF(1), SBUF(10), SBUF(2), acc, acc2, r0, c0, l15, q);
        sa_storeT(lds, SBUF(13), acc, r0, c0, l15, q, false); sa_storeN(lds, SBUF(8), acc2, r0, c0, l15, q); sa_storeT(lds, SBUF(9), acc2, r0, c0, l15, q, false);
        SA_BAR();
        sa_loadT(lds, SBUF(13), acc, r0, c0, l15, q); sa_zero(acc2); sa_mm_a2(lds, SBUF(8), SBUF(13), SBUF(9), acc, acc2, r0, c0, l15, q);
        sa_storeT(lds, SBUF(10), acc, r0, c0, l15, q, false); sa_storeN(lds, SBUF(1), acc2, r0, c0, l15, q); sa_storeT(lds, SBUF(2), acc2, r0, c0, l15, q, false);
        SA_BAR();
        sa_loadT(lds, SBUF(10), acc, r0, c0, l15, q); sa_zero(acc2); sa_mm_a2(lds, SBUF(1), SBUF(10), SBUF(2), acc, acc2, r0, c0, l15, q);
        sa_storeT(lds, SBUF(13), acc, r0, c0, l15, q, false); sa_storeN(lds, SBUF(8), acc2, r0, c0, l15, q); sa_storeT(lds, SBUF(9), acc2, r0, c0, l15, q, false);
        SA_BAR();
        sa_loadT(lds, SBUF(13), acc, r0, c0, l15, q); sa_zero(acc2); sa_mm_a2(lds, SBUF(8), SBUF(13), SBUF(9), acc, acc2, r0, c0, l15, q);
        sa_storeT(lds, SBUF(10), acc, r0, c0, l15, q, false); sa_storeN(lds, SBUF(1), acc2, r0, c0, l15, q);
        SA_BAR();
        sa_loadT(lds, SBUF(10), acc, r0, c0, l15, q); sa_mm(lds, SBUF(1), SBUF(10), acc, r0, c0, l15, q); sa_storeN(lds, SBUF(13), acc, r0, c0, l15, q);
        sa_zero(acc); sa_mm(lds, SBUF(11), SBUF(7), acc, r0, c0, l15, q); sa_storeT(lds, SBUF(2), acc, r0, c0, l15, q, false);
        SA_BAR();
        sa_zero(acc); sa_zero(acc2); sa_mm_a2(lds, SBUF(13), SBUF(4), SBUF(2), acc, acc2, r0, c0, l15, q);
        sa_storeT(lds, SBUF(8), acc, r0, c0, l15, q, false); sa_storeT(lds, SBUF(9), acc2, r0, c0, l15, q, false);
        SA_BAR();
        const size_t ub = (size_t)unit * 4096;
        f32x4s accR[2], accQ[2];
        sa_zero(acc); sa_zero(accR); sa_mm_a2(lds, SBUF(8), SBUF(5), SA_B14, acc, accR, r0, c0, l15, q);
        sa_zero(accQ); sa_zero(acc2);
        sa_mm_b2(lds, SBUF(6), SBUF(12), SBUF(7), accQ, acc2, r0, c0, l15, q);
        sa_mm_b2(lds, SBUF(5), SA_B14, SBUF(9), accQ, acc2, r0, c0, l15, q);
        {
#pragma unroll
            for (int n = 0; n < 2; ++n) { const int k = c0 + 16 * n + l15; float tc = 0.f;
#pragma unroll
                for (int ww = 0; ww < 8; ++ww) tc += tot[ww * 64 + k];
                const float gam = __expf(tc);
                const int j0 = r0 + 4 * q, o = j0 & 15, jp = (j0 & ~15) | ((o & 4) << 1) | ((o & 8) >> 1);
                float v[4];
#pragma unroll
                for (int i = 0; i < 4; ++i) v[i] = acc[n][i] + ((j0 + i) == k ? gam : 0.f);
                v2u wv; wv.x = pk2(v[0], v[1]); wv.y = pk2(v[2], v[3]);
                *(LAS v2u*)(lds + SBUF(1) + k * SA_PITCH + jp * 2) = wv; }
        }
        {
#pragma unroll
            for (int n = 0; n < 2; ++n) { v2u wv; wv.x = pk2(accQ[n][0], accQ[n][1]); wv.y = pk2(accQ[n][2], accQ[n][3]); const int k0 = r0 + 4 * q;
                *(LAS v2u*)(lds + SBUF(4) + (c0 + 16 * n + l15) * SA_PITCH + ((k0 & 32) + 16 * ((k0 >> 2) & 1) + 4 * ((k0 & 31) >> 3)) * 2) = wv; }
        }
        {
#pragma unroll
            for (int n = 0; n < 2; ++n) { const int tk = c0 + 16 * n + l15, k0 = r0 + 4 * q;
                const v2u rv = *(const LAS v2u*)(lds + SBUF(3) + tk * SA_PITCH + k0 * 2);
                v2u wv; wv.x = pk2(accR[n][0] + bflo(rv.x), accR[n][1] + bfhi(rv.x)); wv.y = pk2(accR[n][2] + bflo(rv.y), accR[n][3] + bfhi(rv.y));
                *(LAS v2u*)(lds + SBUF(2) + tk * SA_PITCH + k0 * 2) = wv; }
        }
        sa_storeT(lds, SBUF(10), acc2, r0, c0, l15, q, false);
        SA_BAR();
        {   const int tid_ = w * 64 + lane, row = tid_ >> 3, cc = tid_ & 7;
            *(v4u*)(Pg + ub + row * 64 + 8 * cc) = *(const LAS v4u*)(lds + SBUF(1) + row * SA_PITCH + 16 * cc);
            *(v4u*)(RHg + ub + row * 64 + 8 * cc) = *(const LAS v4u*)(lds + SBUF(2) + row * SA_PITCH + 16 * cc);
            *(v4u*)(QTg + ub + row * 64 + 8 * cc) = *(const LAS v4u*)(lds + SBUF(4) + row * SA_PITCH + 16 * cc);
            *(v4u*)(YVTg + ub + row * 64 + 8 * cc) = *(const LAS v4u*)(lds + SBUF(10) + row * SA_PITCH + 16 * cc); }
    }
}
__device__ __forceinline__ void ph_scan_b(const Ctx& C) {
    PHASE_BASES(); const int lane = P_lane;
    const bf16* Pg = (const bf16*)(ws + WS_SP); const bf16* QTg = (const bf16*)(ws + WS_SQT); bf16* HS = (bf16*)(ws + WS_SHS);
    const int r32 = lane & 31, hi = lane >> 5;
    if (P_wave != 0) return;
    for (int task = P_bid; task < 64; task += P_G) {
        const int bh = task >> 1, vb = task & 1, vcol = 32 * vb + r32;
        f32x16 h0, h1;
#pragma unroll
        for (int i = 0; i < 16; ++i) { h0[i] = 0.f; h1[i] = 0.f; }
        v4u paA[2][2][2], qqA[2][2], paB[2][2][2], qqB[2][2], paC[2][2][2], qqC[2][2];
#define SB_LOAD(PA, QQ, cc) do { const size_t ub_ = ((size_t)bh * 64 + (cc)) * 4096; \
            _Pragma("unroll") for (int t1 = 0; t1 < 2; ++t1) { \
                _Pragma("unroll") for (int t0 = 0; t0 < 2; ++t0) _Pragma("unroll") for (int s = 0; s < 2; ++s) PA[t1][t0][s] = *(const v4u*)(Pg + ub_ + (32 * t1 + r32) * 64 + 32 * t0 + 16 * s + 8 * hi); \
                QQ[t1][0] = *(const v4u*)(QTg + ub_ + vcol * 64 + 32 * t1 + 16 * hi); QQ[t1][1] = *(const v4u*)(QTg + ub_ + vcol * 64 + 32 * t1 + 16 * hi + 8); } } while (0)
#define SB_STEP(cc, PA, QQ, PN, QN) do { \
            bf16* hs = HS + ((size_t)bh * 64 + (cc)) * 4096 + vcol * 64; \
            v4u hb[2][2]; \
            _Pragma("unroll") for (int s = 0; s < 2; ++s) _Pragma("unroll") for (int e = 0; e < 4; ++e) { hb[0][s][e] = pk2(h0[8 * s + 2 * e], h0[8 * s + 2 * e + 1]); hb[1][s][e] = pk2(h1[8 * s + 2 * e], h1[8 * s + 2 * e + 1]); } \
            _Pragma("unroll") for (int g = 0; g < 4; ++g) { \
                v2u w0; w0.x = hb[0][g >> 1][2 * (g & 1)]; w0.y = hb[0][g >> 1][2 * (g & 1) + 1]; *(v2u*)(hs + 8 * g + 4 * hi) = w0; \
                v2u w1; w1.x = hb[1][g >> 1][2 * (g & 1)]; w1.y = hb[1][g >> 1][2 * (g & 1) + 1]; *(v2u*)(hs + 32 + 8 * g + 4 * hi) = w1; } \
            if ((cc) + 2 < 64) SB_LOAD(PN, QN, (cc) + 2); \
            f32x16 n0, n1; \
            _Pragma("unroll") for (int g = 0; g < 4; ++g) { const unsigned a0 = QQ[0][g >> 1][2 * (g & 1)], a1 = QQ[0][g >> 1][2 * (g & 1) + 1], b0 = QQ[1][g >> 1][2 * (g & 1)], b1 = QQ[1][g >> 1][2 * (g & 1) + 1]; \
                n0[4 * g] = bflo(a0); n0[4 * g + 1] = bfhi(a0); n0[4 * g + 2] = bflo(a1); n0[4 * g + 3] = bfhi(a1); \
                n1[4 * g] = bflo(b0); n1[4 * g + 1] = bfhi(b0); n1[4 * g + 2] = bflo(b1); n1[4 * g + 3] = bfhi(b1); } \
            _Pragma("unroll") for (int t0 = 0; t0 < 2; ++t0) _Pragma("unroll") for (int s = 0; s < 2; ++s) { const bf16x8 bfr = __builtin_bit_cast(bf16x8, hb[t0][s]); \
                n0 = __builtin_amdgcn_mfma_f32_32x32x16_bf16(__builtin_bit_cast(bf16x8, PA[0][t0][s]), bfr, n0, 0, 0, 0); \
                n1 = __builtin_amdgcn_mfma_f32_32x32x16_bf16(__builtin_bit_cast(bf16x8, PA[1][t0][s]), bfr, n1, 0, 0, 0); } \
            h0 = n0; h1 = n1; } while (0)
        SB_LOAD(paA, qqA, 0); SB_LOAD(paB, qqB, 1);
#pragma nounroll
        for (int c = 0; c < 63; c += 3) {
            SB_STEP(c, paA, qqA, paC, qqC);
            SB_STEP(c + 1, paB, qqB, paA, qqA);
            SB_STEP(c + 2, paC, qqC, paB, qqB);
        }
        {   bf16* hs = HS + ((size_t)bh * 64 + 63) * 4096 + vcol * 64;
#pragma unroll
            for (int g = 0; g < 4; ++g) {
                v2u w0; w0.x = pk2(h0[4 * g], h0[4 * g + 1]); w0.y = pk2(h0[4 * g + 2], h0[4 * g + 3]); *(v2u*)(hs + 8 * g + 4 * hi) = w0;
                v2u w1; w1.x = pk2(h1[4 * g], h1[4 * g + 1]); w1.y = pk2(h1[4 * g + 2], h1[4 * g + 3]); *(v2u*)(hs + 32 + 8 * g + 4 * hi) = w1; } }
#undef SB_STEP
#undef SB_LOAD
    }
}
__device__ __forceinline__ float grp16_sum(float v) { return pg8::row16_sum(v); }
__device__ __forceinline__ void ph_scan_c(const Ctx& C, int l) {
    PHASE_BASES(); const int lane = P_lane, w = P_wave;
    const bf16* RHg = (const bf16*)(ws + WS_SRH); const bf16* YVTg = (const bf16*)(ws + WS_SYVT); const bf16* HS = (const bf16*)(ws + WS_SHS);
    const bf16* P = (const bf16*)(ws + WS_P); const bf16* G = (const bf16*)(ws + WS_G); const float* BS = (const float*)(ws + WS_BS);
    bf16* YN = (bf16*)(ws + WS_YN); float* SSR = (float*)(ws + WS_SSR);
    const float* mu = INP(13) + l * 1824; const float* gng = INP(22) + l * 512; const float* gnb = INP(23) + l * 512;
    const int slot = w >> 2, r0 = 16 * (w & 3), l15 = lane & 15, q = lane >> 4;
    v2u yv[4]; bf16x8 af[2], bfr[2][4]; v4u pvx[3], gx[2];
#define SC_LOAD(up_) do { const int unit_ = 2 * (up_) + slot, bh_ = unit_ >> 6, c_ = unit_ & 63, b_ = bh_ >> 3, h_ = bh_ & 7; const size_t ub_ = (size_t)unit_ * 4096; const size_t tk_ = (size_t)b_ * SEQ + 64 * c_ + r0; \
        _Pragma("unroll") for (int n = 0; n < 4; ++n) yv[n] = *(const v2u*)(YVTg + ub_ + (16 * n + l15) * 64 + r0 + 4 * q); \
        _Pragma("unroll") for (int ks = 0; ks < 2; ++ks) { af[ks] = *(const bf16x8*)(RHg + ub_ + (r0 + l15) * 64 + 32 * ks + 8 * q); \
            _Pragma("unroll") for (int n = 0; n < 4; ++n) bfr[ks][n] = *(const bf16x8*)(HS + ub_ + (16 * n + l15) * 64 + 32 * ks + 8 * q); } \
        _Pragma("unroll") for (int k = 0; k < 3; ++k) { const int idx = lane + 64 * k; pvx[k] = (v4u){0u, 0u, 0u, 0u}; if (idx < 136) { const int r = idx >> 3, cc = idx & 7; \
            if (r > 0 || (64 * c_ + r0) != 0) pvx[k] = *(const v4u*)(P + (tk_ + r - 1) * NINP + RW_OFF + 1088 + 64 * h_ + 8 * cc); } } \
        _Pragma("unroll") for (int k = 0; k < 2; ++k) { const int idx = lane + 64 * k, r = idx >> 3, cc = idx & 7; gx[k] = *(const v4u*)(G + (tk_ + r) * 512 + 64 * h_ + 8 * cc); } } while (0)
    if (P_bid < 1024) SC_LOAD(P_bid);
    for (int up = P_bid; up < 1024; up += P_G) {
        const int unit = 2 * up + slot, bh = unit >> 6, c = unit & 63, b = bh >> 3, h = bh & 7;
        f32x4s acc[4];
#pragma unroll
        for (int n = 0; n < 4; ++n) acc[n] = (f32x4s){bflo(yv[n].x), bfhi(yv[n].x), bflo(yv[n].y), bfhi(yv[n].y)};
#pragma unroll
        for (int ks = 0; ks < 2; ++ks)
#pragma unroll
            for (int n = 0; n < 4; ++n) acc[n] = __builtin_amdgcn_mfma_f32_16x16x32_bf16(af[ks], bfr[ks][n], acc[n], 0, 0, 0);
        LAS unsigned char* wl = C.lds + w * 8192;
#pragma unroll
        for (int k = 0; k < 3; ++k) { const int idx = lane + 64 * k; if (idx < 136) { const int r = idx >> 3, cc = idx & 7; *(LAS v4u*)(wl + r * 144 + 16 * cc) = pvx[k]; } }
#pragma unroll
        for (int k = 0; k < 2; ++k) { const int idx = lane + 64 * k, r = idx >> 3, cc = idx & 7; *(LAS v4u*)(wl + 2560 + r * 144 + 16 * cc) = gx[k]; }
        float gg[4], gb[4], muv[4], bsv[4];
#pragma unroll
        for (int n = 0; n < 4; ++n) { const int ch = 64 * h + 16 * n + l15; gg[n] = gng[ch]; gb[n] = gnb[ch]; muv[n] = mu[1088 + ch]; }
        const size_t tok0 = (size_t)b * SEQ + 64 * c + r0;
#pragma unroll
        for (int i = 0; i < 4; ++i) bsv[i] = BS[(tok0 + 4 * q + i) * 8 + h];
        asm volatile("" ::: "memory");
        if (up + P_G < 1024) SC_LOAD(up + P_G);
#pragma unroll
        for (int i = 0; i < 4; ++i) {
            const int rr = 4 * q + i; const size_t token = tok0 + rr;
            const float mean = grp16_sum((acc[0][i] + acc[1][i]) + (acc[2][i] + acc[3][i])) * (1.0f / 64.0f);
            float d[4]; float v2s = 0.f;
#pragma unroll
            for (int n = 0; n < 4; ++n) { d[n] = acc[n][i] - mean; v2s += d[n] * d[n]; }
            const float rstd = rsqrtf(grp16_sum(v2s) * (1.0f / 64.0f) + 64e-5f);
            const float bs = bsv[i];
            float sq = 0.f;
#pragma unroll
            for (int n = 0; n < 4; ++n) { const int ch = 16 * n + l15;
                const float pvc = bf2f(((const LAS unsigned short*)(wl + (rr + 1) * 144))[ch]), pvp = bf2f(((const LAS unsigned short*)(wl + rr * 144))[ch]);
                const float v = pvc + muv[n] * (pvp - pvc);
                const float gt = bf2f(((const LAS unsigned short*)(wl + 2560 + rr * 144))[ch]);
                const float o = (d[n] * rstd * gg[n] + gb[n] + bs * v) * gt;
                ((LAS unsigned short*)(wl + 5120 + rr * 144))[ch] = (unsigned short)f2bf(o); sq += o * o;
            }
            sq = grp16_sum(sq);
            if (l15 == 0) SSR[token * 8 + h] = sq;
        }
#pragma unroll
        for (int k = 0; k < 2; ++k) { const int idx = lane + 64 * k, r = idx >> 3, cc = idx & 7;
            *(v4u*)(YN + (tok0 + r) * 1024 + 512 + 64 * h + 8 * cc) = *(const LAS v4u*)(wl + 5120 + r * 144 + 16 * cc); }
    }
}

__device__ __forceinline__ void ph_mix(const Ctx& C, int l) {
    ph_scan_b(C);
    PHASE_BASES();
    unsigned* qbase = (unsigned*)(ws + WS_CTL) + 3072 + 128 * l;
    volatile LAS unsigned* slot = (volatile LAS unsigned*)(C.lds + MISC_OFF) + 16;
    const int xcc = (int)(xb_xcc_id() & 7u);
    bool own = true;
    for (;;) {
        __syncthreads();
        if (P_tid == 0) {
            unsigned res = 0xffffffffu;
            if (own) { const unsigned v = __hip_atomic_fetch_add(qbase + 16 * xcc, 1u, __ATOMIC_RELAXED, __HIP_MEMORY_SCOPE_AGENT); if (v < 64u) res = ((unsigned)xcc << 8) | v; }
            if (res == 0xffffffffu) {
                unsigned c[8];
#pragma unroll
                for (int k = 1; k < 8; ++k) c[k] = __hip_atomic_load(qbase + 16 * ((xcc + k) & 7), __ATOMIC_RELAXED, __HIP_MEMORY_SCOPE_AGENT);
#pragma unroll
                for (int k = 1; k < 8; ++k) if (res == 0xffffffffu && c[k] < 64u) { const int qk = (xcc + k) & 7;
                    const unsigned v = __hip_atomic_fetch_add(qbase + 16 * qk, 1u, __ATOMIC_RELAXED, __HIP_MEMORY_SCOPE_AGENT); if (v < 64u) res = ((unsigned)qk << 8) | v; }
            }
            *slot = res;
        }
        __syncthreads();
        const unsigned r = (unsigned)__builtin_amdgcn_readfirstlane((int)*slot);
        if (r == 0xffffffffu) break;
        const int qk = (int)(r >> 8), j = (int)(r & 255u);
        if (qk != xcc) own = false;
        att_unit(C, (j >> 2) * 32 + 4 * qk + (j & 3));
    }
    cvt_drain_mix(C, l);
}

constexpr int PF_QP = 528, PF_KVP = 272, PF_LAP = 592;
constexpr int PF_AQ = 0, PF_AKV = PF_AQ + 64 * PF_QP, PF_ALA = PF_AKV + 64 * PF_KVP, PF_KPE = PF_ALA + 64 * PF_LAP, PF_STG = PF_KPE + 64 * 64;
constexpr int PF_SP = 272, PF_STGW = 16 * PF_SP, PF_END = PF_STG + 8 * PF_STGW;
static_assert(PF_END <= RING_BYTES, "PREP_F LDS");
typedef float f32x4p __attribute__((ext_vector_type(4)));
template <int NT, int KS> __device__ __forceinline__ void pf_mm(f32x4p (&acc)[4][NT], const LAS unsigned char* lds, int aoff, int apitch, int acol0, const bf16* Bt, int brow0, int ldb, int bcol0, int l15, int q) {
    bf16x8 bb[3][NT];
    const bf16* bp = Bt + (size_t)(brow0 + l15) * ldb + bcol0 + 8 * q;
#define PF_LDB(ks_) do { _Pragma("unroll") for (int n = 0; n < NT; ++n) bb[(ks_) % 3][n] = *(const bf16x8*)(bp + (size_t)(16 * n) * ldb + 32 * (ks_)); } while (0)
    PF_LDB(0); if (KS > 1) PF_LDB(1);
#pragma unroll
    for (int ks = 0; ks < KS; ++ks) {
        if (ks + 2 < KS) PF_LDB(ks + 2);
#pragma unroll
        for (int m = 0; m < 4; ++m) {
            const bf16x8 a = *(const LAS bf16x8*)(lds + aoff + (16 * m + l15) * apitch + (acol0 + 32 * ks) * 2 + 16 * q);
#pragma unroll
            for (int n = 0; n < NT; ++n) acc[m][n] = __builtin_amdgcn_mfma_f32_16x16x32_bf16(a, bb[ks % 3][n], acc[m][n], 0, 0, 0);
        }
        asm volatile("" ::: "memory");
    }
#undef PF_LDB
}
template <int NT> __device__ __forceinline__ void pf_out_bf16(const float (&v)[NT][4], LAS unsigned char* stg, bf16* g0, int gstride, int lane, int l15, int q) {
#pragma unroll
    for (int n = 0; n < NT; ++n)
#pragma unroll
        for (int i = 0; i < 4; ++i) ((LAS unsigned short*)(stg + (4 * q + i) * PF_SP))[16 * n + l15] = (unsigned short)f2bf(v[n][i]);
    constexpr int CH = 2 * NT;
#pragma unroll
    for (int k = 0; k < (16 * CH) / 64; ++k) { const int idx = lane + 64 * k, r = idx / CH, c = idx - r * CH;
        *(v4u*)(g0 + (size_t)r * gstride + 8 * c) = *(const LAS v4u*)(stg + r * PF_SP + 16 * c); }
}
__device__ __forceinline__ void pf_out_f32x64(const float (&v)[4][4], LAS unsigned char* stg, float* g0, int gstride, int lane, int l15, int q) {
#pragma unroll
    for (int hf = 0; hf < 2; ++hf) {
#pragma unroll
        for (int n = 0; n < 2; ++n)
#pragma unroll
            for (int i = 0; i < 4; ++i) ((LAS float*)(stg + (4 * q + i) * PF_SP))[16 * n + l15] = v[2 * hf + n][i];
#pragma unroll
        for (int k = 0; k < 2; ++k) { const int idx = lane + 64 * k, r = idx >> 3, c = idx & 7;
            *(f32x4*)(g0 + (size_t)r * gstride + 32 * hf + 4 * c) = *(const LAS f32x4*)(stg + r * PF_SP + 16 * c); }
    }
}
#ifndef PF_PARTS
#define PF_PARTS 7
#endif
__device__ __forceinline__ void ph_prep_f(const Ctx& C, int l) {
    PHASE_BASES(); const int lane = P_lane, w = P_wave;
    const bf16* P = (const bf16*)(ws + WS_P);
    LAS unsigned char* lds = C.lds;
    const int l15_ = lane & 15, q_ = lane >> 4;
    if (P_bid < MTOK / 64) {
        const int u = P_bid; const int t0 = 64 * u, b = t0 >> 12, s0 = t0 & (SEQ - 1);
        __syncthreads();
        {
            const float* gq = INP(7) + l * 256; const float* gkv = INP(9) + l * 128; const float* mu = INP(13) + l * 1824;
#pragma unroll 4
            for (int j = 0; j < 8; ++j) {
                const int tl = 8 * w + j, row = t0 + tl; const bf16* pr = P + (size_t)row * NINP; const bool hasprev = (s0 + tl) != 0;
                {   const v2u raw = *(const v2u*)(pr + 4 * lane);
                    const float v0 = bflo(raw.x), v1 = bfhi(raw.x), v2 = bflo(raw.y), v3 = bfhi(raw.y);
                    const float rs = rsqrtf(wave_sum((v0 * v0 + v1 * v1) + (v2 * v2 + v3 * v3)) * (1.0f / 256.0f) + EPS);
                    const f32x4 g = *(const f32x4*)(gq + 4 * lane);
                    v2u wq; wq.x = pk2(v0 * rs * g[0], v1 * rs * g[1]); wq.y = pk2(v2 * rs * g[2], v3 * rs * g[3]);
                    *(LAS v2u*)(lds + PF_AQ + tl * PF_QP + 8 * lane) = wq; }
                {   const unsigned raw = *(const unsigned*)(pr + 256 + 2 * lane);
                    const float v0 = bflo(raw), v1 = bfhi(raw);
                    const float rs = rsqrtf(wave_sum(v0 * v0 + v1 * v1) * (1.0f / 128.0f) + EPS);
                    *(LAS unsigned*)(lds + PF_AKV + tl * PF_KVP + 4 * lane) = pk2(v0 * rs * gkv[2 * lane], v1 * rs * gkv[2 * lane + 1]); }
                if (lane < 16) *(LAS unsigned*)(lds + PF_KPE + tl * 64 + 4 * lane) = *(const unsigned*)(pr + 384 + 2 * lane);
                if (lane < 36) {
                    float o[8];
                    if (lane < 8) { ps8(pr, hasprev, mu, 512 + 8 * lane, o);
#pragma unroll
                        for (int e = 0; e < 8; ++e) o[e] = 1.0f - 2.0f * __builtin_amdgcn_rcpf(1.0f + __expf(2.0f * o[e])); }
                    else if (lane < 16) { ps8(pr, hasprev, mu, 1600 + 8 * (lane - 8), o); }
                    else if (lane < 36) { ps8(pr, hasprev, mu, 1664 + 8 * (lane - 16), o);
#pragma unroll
                        for (int e = 0; e < 8; ++e) o[e] = __builtin_amdgcn_rcpf(1.0f + __expf(-o[e])); }
                    *(LAS v4u*)(lds + PF_ALA + tl * PF_LAP + 16 * lane) = pack8(o);
                }
            }
        }
        LDS_WAIT(); __syncthreads();
        LAS unsigned char* stg = lds + PF_STG + w * PF_STGW;
        const int h = w; const size_t hb = (size_t)(b * NHEAD + h) * SEQ + s0;
        if (PF_PARTS & 1) { int l15 = l15_, q = q_; asm volatile("" : "+v"(l15), "+v"(q));
            const float rfreq = __builtin_amdgcn_exp2f(-(float)l15 * (13.287712379549449f / 16.0f)) * 0.15915494309189535f;
            f32x4p acc[4][6];
#pragma unroll
            for (int m = 0; m < 4; ++m)
#pragma unroll
                for (int n = 0; n < 6; ++n) acc[m][n] = (f32x4p){0.f, 0.f, 0.f, 0.f};
            pf_mm<6, 8>(acc, lds, PF_AQ, PF_QP, 0, (const bf16*)(ws + WS_WQ), 96 * h, 256, 0, l15, q);
            const float* qn = INP(11) + l * 96; float gn[6];
#pragma unroll
            for (int n = 0; n < 6; ++n) gn[n] = qn[16 * n + l15];
            const float QSCALE = 0.10206207261596575f * 1.4426950408889634f;
            bf16* Q = (bf16*)(ws + WS_Q);
#pragma unroll
            for (int m = 0; m < 4; ++m) {
                float y[6][4];
#pragma unroll
                for (int i = 0; i < 4; ++i) { const int tl = 16 * m + 4 * q + i;
                    float ss = 0.f;
#pragma unroll
                    for (int n = 0; n < 6; ++n) ss += acc[m][n][i] * acc[m][n][i];
                    const float rs = rsqrtf(pg8::row16_sum(ss) * (1.0f / 96.0f) + EPS) * QSCALE;
                    const float rv = __builtin_amdgcn_fractf((float)(s0 + tl) * rfreq); const float cs = __builtin_amdgcn_cosf(rv), sn = __builtin_amdgcn_sinf(rv);
#pragma unroll
                    for (int n = 0; n < 6; ++n) y[n][i] = acc[m][n][i] * rs * gn[n];
                    const float r4 = y[4][i] * cs - y[5][i] * sn, r5 = y[5][i] * cs + y[4][i] * sn; y[4][i] = r4; y[5][i] = r5; }
                pf_out_bf16<6>(y, stg, Q + (hb + 16 * m) * 96, 96, lane, l15, q);
            }
        }
        asm volatile("" ::: "memory");
        if (PF_PARTS & 2) { int l15 = l15_, q = q_; asm volatile("" : "+v"(l15), "+v"(q));
            const float rfreq = __builtin_amdgcn_exp2f(-(float)l15 * (13.287712379549449f / 16.0f)) * 0.15915494309189535f;
            const float* kn = INP(12) + l * 96; float gn[6];
#pragma unroll
            for (int n = 0; n < 6; ++n) gn[n] = kn[16 * n + l15];
            bf16* K = (bf16*)(ws + WS_K); bf16* V = (bf16*)(ws + WS_V);
            {   f32x4p acc[4][4];
#pragma unroll
                for (int m = 0; m < 4; ++m)
#pragma unroll
                    for (int n = 0; n < 4; ++n) acc[m][n] = (f32x4p){0.f, 0.f, 0.f, 0.f};
                pf_mm<4, 4>(acc, lds, PF_AKV, PF_KVP, 0, (const bf16*)(ws + WS_WKV), 128 * h, 256, 0, l15, q);
#pragma unroll
                for (int m = 0; m < 4; ++m) {
                    float y[6][4];
#pragma unroll
                    for (int i = 0; i < 4; ++i) { const int tl = 16 * m + 4 * q + i;
                        const float p4 = bf2f(*(const LAS unsigned short*)(lds + PF_KPE + tl * 64 + 2 * l15)), p5 = bf2f(*(const LAS unsigned short*)(lds + PF_KPE + tl * 64 + 32 + 2 * l15));
                        float ss = p4 * p4 + p5 * p5;
#pragma unroll
                        for (int n = 0; n < 4; ++n) ss += acc[m][n][i] * acc[m][n][i];
                        const float rs = rsqrtf(pg8::row16_sum(ss) * (1.0f / 96.0f) + EPS);
                        const float rv = __builtin_amdgcn_fractf((float)(s0 + tl) * rfreq); const float cs = __builtin_amdgcn_cosf(rv), sn = __builtin_amdgcn_sinf(rv);
                        const float y4 = p4 * rs * gn[4], y5 = p5 * rs * gn[5];
#pragma unroll
                        for (int n = 0; n < 4; ++n) y[n][i] = acc[m][n][i] * rs * gn[n];
                        y[4][i] = y4 * cs - y5 * sn; y[5][i] = y5 * cs + y4 * sn; }
                    pf_out_bf16<6>(y, stg, K + (hb + 16 * m) * 96, 96, lane, l15, q);
                }
            }
            asm volatile("" ::: "memory");
            {   f32x4p acc[4][4];
#pragma unroll
                for (int m = 0; m < 4; ++m)
#pragma unroll
                    for (int n = 0; n < 4; ++n) acc[m][n] = (f32x4p){0.f, 0.f, 0.f, 0.f};
                pf_mm<4, 4>(acc, lds, PF_AKV, PF_KVP, 0, (const bf16*)(ws + WS_WKV), 128 * h + 64, 256, 0, l15, q);
#pragma unroll
                for (int m = 0; m < 4; ++m) { float y[4][4];
#pragma unroll
                    for (int n = 0; n < 4; ++n)
#pragma unroll
                        for (int i = 0; i < 4; ++i) y[n][i] = acc[m][n][i];
                    pf_out_bf16<4>(y, stg, V + (hb + 16 * m) * 64, 64, lane, l15, q); }
            }
        }
        asm volatile("" ::: "memory");
        if (PF_PARTS & 4) { int l15 = l15_, q = q_; asm volatile("" : "+v"(l15), "+v"(q));
            const float* w0 = INP(14) + l * 512; const float* a0 = INP(16) + l * 512;
            float* LW = (float*)(ws + WS_DEC); bf16* AS = (bf16*)(ws + WS_AS); bf16* G = (bf16*)(ws + WS_G);
            const bf16* WL = (const bf16*)(ws + WS_WLORA);
            {   asm volatile("" : "+v"(l15), "+v"(q)); f32x4p acc[4][4];
#pragma unroll
                for (int m = 0; m < 4; ++m)
#pragma unroll
                    for (int n = 0; n < 4; ++n) acc[m][n] = (f32x4p){0.f, 0.f, 0.f, 0.f};
                pf_mm<4, 2>(acc, lds, PF_ALA, PF_LAP, 0, WL, 64 * h, 384, 0, l15, q);
                float bw[4];
#pragma unroll
                for (int n = 0; n < 4; ++n) bw[n] = w0[64 * h + 16 * n + l15];
#pragma unroll
                for (int m = 0; m < 4; ++m) { float y[4][4];
#pragma unroll
                    for (int n = 0; n < 4; ++n)
#pragma unroll
                        for (int i = 0; i < 4; ++i) y[n][i] = -0.60653065971f * __builtin_amdgcn_rcpf(1.0f + __expf(-(acc[m][n][i] + bw[n])));
                    pf_out_f32x64(y, stg, LW + (size_t)(t0 + 16 * m) * 512 + 64 * h, 512, lane, l15, q); }
            }
            asm volatile("" ::: "memory");
            {   asm volatile("" : "+v"(l15), "+v"(q)); f32x4p acc[4][4];
#pragma unroll
                for (int m = 0; m < 4; ++m)
#pragma unroll
                    for (int n = 0; n < 4; ++n) acc[m][n] = (f32x4p){0.f, 0.f, 0.f, 0.f};
                pf_mm<4, 5>(acc, lds, PF_ALA, PF_LAP, 128, WL, 1024 + 64 * h, 384, 128, l15, q);
#pragma unroll
                for (int m = 0; m < 4; ++m) { float y[4][4];
#pragma unroll
                    for (int n = 0; n < 4; ++n)
#pragma unroll
                        for (int i = 0; i < 4; ++i) y[n][i] = acc[m][n][i];
                    pf_out_bf16<4>(y, stg, G + (size_t)(t0 + 16 * m) * 512 + 64 * h, 512, lane, l15, q); }
            }
            asm volatile("" ::: "memory");
            {   asm volatile("" : "+v"(l15), "+v"(q)); f32x4p acc[4][4];
#pragma unroll
                for (int m = 0; m < 4; ++m)
#pragma unroll
                    for (int n = 0; n < 4; ++n) acc[m][n] = (f32x4p){0.f, 0.f, 0.f, 0.f};
                pf_mm<4, 2>(acc, lds, PF_ALA, PF_LAP, 64, WL, 512 + 64 * h, 384, 64, l15, q);
                float ba[4];
#pragma unroll
                for (int n = 0; n < 4; ++n) ba[n] = a0[64 * h + 16 * n + l15];
#pragma unroll
                for (int m = 0; m < 4; ++m) { float y[4][4];
#pragma unroll
                    for (int n = 0; n < 4; ++n)
#pragma unroll
                        for (int i = 0; i < 4; ++i) y[n][i] = __builtin_amdgcn_rcpf(1.0f + __expf(-(acc[m][n][i] + ba[n])));
                    pf_out_bf16<4>(y, stg, AS + (size_t)(t0 + 16 * m) * 512 + 64 * h, 512, lane, l15, q); }
            }
            asm volatile("s_waitcnt vmcnt(0)" ::: "memory"); __syncthreads();
            {
                const float* mu = INP(13) + l * 1824; const float* k_k = INP(19) + l * 512; const float* k_a = INP(20) + l * 512; const float* r_k = INP(21) + l * 512;
                float* KN = (float*)(ws + WS_KN); float* BS = (float*)(ws + WS_BS);
                float kkc[8], kac[8], rkc[8];
#pragma unroll
                for (int e = 0; e < 8; ++e) { kkc[e] = k_k[8 * lane + e]; kac[e] = k_a[8 * lane + e]; rkc[e] = r_k[8 * lane + e]; }
#pragma unroll 2
                for (int j = 0; j < 8; ++j) {
                    const int tl = 8 * w + j; const size_t row = (size_t)t0 + tl; const bf16* pr = P + row * NINP; const bool hasprev = (s0 + tl) != 0;
                    float r[8], k[8], a[8];
                    ps8(pr, hasprev, mu, 8 * lane, r); ps8(pr, hasprev, mu, 576 + 8 * lane, k);
                    unpk8(*(const v4u*)(AS + row * 512 + 8 * lane), a);
                    float n2 = 0.f, bs = 0.f;
#pragma unroll
                    for (int e = 0; e < 8; ++e) { const float kk = k[e] * kkc[e]; n2 += kk * kk; bs += r[e] * (k[e] * (1.0f + (a[e] - 1.0f) * kac[e])) * rkc[e]; }
                    n2 = pg8::oct_sum(n2); bs = pg8::oct_sum(bs);
                    if ((lane & 7) == 0) { KN[row * 8 + (lane >> 3)] = 1.0f / fmaxf(sqrtf(n2), 1e-12f); BS[row * 8 + (lane >> 3)] = bs; }
                }
            }
        }
    }
}

constexpr int N_LAYER_PHASES = 13;
template <int PH> __global__ void __launch_bounds__(NWAVES * 64, 2) fwd(Args args) {
    extern __shared__ __attribute__((aligned(16))) unsigned char lds_raw[];
    Ctx C;
    C.lds = (LAS unsigned char*)lds_raw; C.X = args.out; C.ws = args.ws; C.ka = (const __attribute__((address_space(4))) unsigned char*)__builtin_amdgcn_kernarg_segment_ptr();
    C.G = gridDim.x; C.bid = blockIdx.x; C.wave = __builtin_amdgcn_readfirstlane(threadIdx.x >> 6);
    constexpr bool all = PH < 0;
    volatile LAS unsigned* MISC = (volatile LAS unsigned*)(C.lds + MISC_OFF);
    for (int u = threadIdx.x; u < (LDS_BYTES - RING_BYTES) / 4; u += NWAVES * 64) ((LAS unsigned*)(C.lds + RING_BYTES))[u] = 0u;
    __syncthreads();
    XcdBarrier bar; bar.bar = (unsigned*)(args.ws + WS_CTL) + 4096; bar.x = 0; bar.st = nullptr;
    if (all) bar = xcd_barrier_post((unsigned*)(args.ws + WS_CTL) + 4096, MISC + 8);
#define SEAM() do { if (all) xcd_barrier(bar); } while (0)
#define RUN(k) (all || PH == (k))
#ifndef PROBE_MASK
#define PROBE_MASK 0u
#endif
#define PROBE_HALF(k) ((((PROBE_MASK >> (k)) & 1u)) ? 0.5f : 1.0f)
#define REP(k) for (int rep_ = 0; rep_ < (((PROBE_MASK >> (k)) & 1u) ? 2 : 1); ++rep_)

    if (all || PH == 0) { ph_init(C); if (all) { ph_cvt_early0(C); SEAM(); } }
    if (!all && PH == 1) ph_cvt_early0(C);
    const int l_lo = all ? 0 : args.layer, l_hi = all ? NLAYER : args.layer + 1;
#pragma nounroll
    for (int l = l_lo; l < l_hi; ++l) {
        if (RUN(2)) REP(2) { PHASE_BASES(); float* rss = (float*)(ws + WS_RSS); bf16* XB = (bf16*)(ws + WS_XB); bf16* HB = (bf16*)(ws + WS_HB);
            pg8::Gemm g{XB, (const bf16*)(ws + WS_WGU1), MTOK, 2 * DFF, DM, DM, DM}; pg8::StaticOrder S; S.init(MTOK, 2 * DFF, P_G, P_bid);
            pg8::EpiSwiGLU E{HB, rss, DFF};
            const bool spare = 5 * P_G + P_bid >= 1408;
            if (spare) { cvt_take(C, 1, l, 1, CVT_NCH_L); __syncthreads(); }
            pg8::gemm_phase<pg8::EpiSwiGLU, pg8::StaticOrder, true, true>(C.lds, g, S, E, C.wave); if (spare) cvt_take(C, 1, l, 1, CVT_NCH_L); SEAM();
        }
        if (RUN(3)) REP(3) { PHASE_BASES(); float* rss = (float*)(ws + WS_RSS); bf16* XB = (bf16*)(ws + WS_XB); bf16* HB = (bf16*)(ws + WS_HB);
            pg8::Gemm g{HB, (const bf16*)(ws + WS_WDN1), MTOK, DM, DFF, DFF, DFF}; pg8::StaticOrder S; S.init(MTOK, DM, P_G, P_bid);
            pg8::EpiResid E{nullptr, XB, rss, 0.5f * PROBE_HALF(3), nullptr};
            pg8::gemm_phase<pg8::EpiResid, pg8::StaticOrder, true, true>(C.lds, g, S, E, C.wave); SEAM();
        }
        if (RUN(4)) REP(4) { PHASE_BASES(); float* rss = (float*)(ws + WS_RSS); bf16* XB = (bf16*)(ws + WS_XB);
            pg8::Gemm g{XB, (const bf16*)(ws + WS_WIN), MTOK, NINP, DM, DM, DM}; pg8::StaticOrder S; S.init(MTOK, NINP, P_G, P_bid);
            pg8::EpiStore E{(bf16*)(ws + WS_P), NINP, rss};
            pg8::gemm_phase<pg8::EpiStore, pg8::StaticOrder, true, true>(C.lds, g, S, E, C.wave); if (2 * P_G + P_bid >= 576) { const int nl = cvt_take(C, 1, l, 2, CVT_NCH_L); cvt_take(C, 0, l + 1, 2 - nl, CVT_NCH_E01); } SEAM();
        }
        if (RUN(20)) { ph_prep_f(C, l);
            asm volatile("s_waitcnt vmcnt(0)" ::: "memory"); __syncthreads();
            ph_scan_a(C, l); SEAM(); }
        if (RUN(18)) { ph_mix(C, l); SEAM(); }
        if (RUN(17)) REP(17) { ph_scan_c(C, l); SEAM(); }
        if (RUN(11)) REP(11) { PHASE_BASES(); float* rss = (float*)(ws + WS_RSS); bf16* XB = (bf16*)(ws + WS_XB);
            if (P_G == 256) {
                pg8::Gemm g{(const bf16*)(ws + WS_YN), (const bf16*)(ws + WS_WOUT), MTOK, DM, DM, DM, DM}; pg8::StaticOrder S; S.init(MTOK, DM, P_G, P_bid);
                LAS float* tab = (LAS float*)(C.lds + RING_BYTES + 2048);
                { pg8::Unit u0; if (S.next(0, u0) && P_tid < 256) { const int row = u0.pm * 256 + P_tid; const float* pa = (const float*)(ws + WS_SSA) + (size_t)row * 8; const float* pr = (const float*)(ws + WS_SSR) + (size_t)row * 8;
                    const f32x4 a0 = *(const f32x4*)pa, a1 = *(const f32x4*)(pa + 4), r0 = *(const f32x4*)pr, r1 = *(const f32x4*)(pr + 4);
                    const float sa = ((a0[0] + a0[1]) + (a0[2] + a0[3])) + ((a1[0] + a1[1]) + (a1[2] + a1[3])), sr = ((r0[0] + r0[1]) + (r0[2] + r0[3])) + ((r1[0] + r1[1]) + (r1[2] + r1[3]));
                    const float ra = rsqrtf(sa * (1.0f / 512.0f) + EPS), rr = rsqrtf(sr * (1.0f / 512.0f) + EPS) * PROBE_HALF(11);
                    tab[2 * P_tid] = ra * PROBE_HALF(11) / rr; tab[2 * P_tid + 1] = rr; } }
                LDS_WAIT(); __syncthreads();
                pg8::EpiResidMid E{nullptr, XB, rss, (const LAS float*)tab};
                pg8::gemm_phase<pg8::EpiResidMid, pg8::StaticOrder, true, true>(C.lds, g, S, E, C.wave);
            }
            SEAM();
        }
        if (RUN(12)) REP(12) { PHASE_BASES(); float* rss = (float*)(ws + WS_RSS); bf16* XB = (bf16*)(ws + WS_XB); bf16* HB = (bf16*)(ws + WS_HB);
            pg8::Gemm g{XB, (const bf16*)(ws + WS_WGU2), MTOK, 2 * DFF, DM, DM, DM}; pg8::StaticOrder S; S.init(MTOK, 2 * DFF, P_G, P_bid);
            pg8::EpiSwiGLU E{HB, rss, DFF};
            const bool spare = 5 * P_G + P_bid >= 1408;
            if (spare) { if (!cvt_take(C, 0, l + 1, 1, CVT_NCH_E01)) cvt_take(C, 2, l + 1, 1, CVT_NCH_E); __syncthreads(); }
            pg8::gemm_phase<pg8::EpiSwiGLU, pg8::StaticOrder, true, true>(C.lds, g, S, E, C.wave); if (spare) { if (!cvt_take(C, 0, l + 1, 1, CVT_NCH_E01)) cvt_take(C, 2, l + 1, 1, CVT_NCH_E); } SEAM();
        }
        if (RUN(13)) REP(13) { PHASE_BASES(); float* rss = (float*)(ws + WS_RSS); bf16* XB = (bf16*)(ws + WS_XB); bf16* HB = (bf16*)(ws + WS_HB);
            pg8::Gemm g{HB, (const bf16*)(ws + WS_WDN2), MTOK, DM, DFF, DFF, DFF}; pg8::StaticOrder S; S.init(MTOK, DM, P_G, P_bid);
            pg8::EpiResid E{l == NLAYER - 1 ? C.X : nullptr, XB, rss, 0.5f * PROBE_HALF(13), nullptr};
            pg8::gemm_phase<pg8::EpiResid, pg8::StaticOrder, true, true>(C.lds, g, S, E, C.wave);
            cvt_drain_early(C, l + 1);
            if (l + 1 < l_hi) SEAM();
        }
    }
#undef SEAM
#undef RUN
}

template <int PH> static void launch_phase(int grid, const Args& a, hipStream_t stream) {
    static bool attr_set = false;
    if (!attr_set) { (void)hipFuncSetAttribute((const void*)fwd<PH>, hipFuncAttributeMaxDynamicSharedMemorySize, LDS_BYTES); attr_set = true; }
    hipLaunchKernelGGL(fwd<PH>, dim3(grid), dim3(NWAVES * 64), LDS_BYTES, stream, a);
}
extern "C" void kernel_launch(void* const* d_in, const int* in_sizes, int n_in, void* d_out, int out_size, void* d_ws, size_t ws_size, hipStream_t stream) {
    static int grid = 0;
    if (grid == 0) {
        if (n_in != 31 || out_size != MTOK * DM || ws_size < WS_END) { fprintf(stderr, "kernel_launch: unexpected problem (n_in %d, out %d, ws %zu < %zu); nothing launched\n", n_in, out_size, ws_size, (size_t)WS_END); grid = -1; return; }
        int dev = 0, cus = 0;
        if (hipGetDevice(&dev) != hipSuccess || hipDeviceGetAttribute(&cus, hipDeviceAttributeMultiprocessorCount, dev) != hipSuccess) { grid = -1; return; }
        grid = cus;
        if (grid != 256) { fprintf(stderr, "kernel_launch: built for a 256-CU device, found %d CUs; nothing launched\n", cus); grid = -1; return; }
    }
    if (grid < 0) return;
    (void)hipMemsetAsync((char*)d_ws + WS_CTL, 0, CTL_ZERO_BYTES, stream);
    Args a{};
    for (int i = 0; i < 31; ++i) a.in[i] = (const float*)d_in[i];
    a.out = (float*)d_out; a.ws = (unsigned char*)d_ws;
    a.layer = 0; a.ph = -1;
    launch_phase<-1>(grid, a, stream);
}
```
